# Optimizing an MI355X kernel written in HIP

```python
import jax, jax.numpy as jnp
from jax import lax
import numpy as np


D_MODEL = 4096
BATCH = 4
SEQ = 2048
DEPTH = 4

D_FF = 5632
MIX_WIDTH = D_MODEL
POOL_GROUPS = 4
POOL_GROUP_DIM = MIX_WIDTH // 16
POOL_WIDTH = POOL_GROUPS * POOL_GROUP_DIM
POOL_WINDOWS = (2, 4, 8, 16)
CONV_WIDTH = (MIX_WIDTH - POOL_WIDTH) // 2
CONV_K = 3
SGU_HEAD_DIM = 128
SGU_WIDTH = MIX_WIDTH - POOL_WIDTH - CONV_WIDTH
SGU_HEADS = SGU_WIDTH // SGU_HEAD_DIM
SGU_CHUNK = 128
PROJ_WIDTH = POOL_WIDTH + 3 * CONV_WIDTH + 2 * SGU_WIDTH
PROJ_SPLITS = (POOL_WIDTH,
               POOL_WIDTH + CONV_WIDTH,
               POOL_WIDTH + 2 * CONV_WIDTH,
               POOL_WIDTH + 3 * CONV_WIDTH,
               POOL_WIDTH + 3 * CONV_WIDTH + SGU_WIDTH)
NORM_EPS = 1e-6
LN_EPS = 1e-5

kernel_name = 'hybrid_pool_conv_sgu_macaron'


def rms_norm(x, g):
    xf = x.astype(jnp.float32)
    y = xf * lax.rsqrt(jnp.mean(xf * xf, axis=-1, keepdims=True) + NORM_EPS)
    return (y * g.astype(jnp.float32)).astype(x.dtype)


def swiglu(h, w_gate, w_up, w_down):
    return (jax.nn.silu(h @ w_gate) * (h @ w_up)) @ w_down


def causal_multiscale_pool(a):
    b, t, _ = a.shape
    a4 = a.reshape(b, t, POOL_GROUPS, POOL_GROUP_DIM).astype(jnp.float32)
    cs = jnp.cumsum(a4, axis=1)
    cs = jnp.concatenate([jnp.zeros_like(cs[:, :1]), cs], axis=1)
    pos = jnp.arange(t)
    windows = jnp.array(POOL_WINDOWS, dtype=jnp.int32)
    start = jnp.maximum(pos[:, None] + 1 - windows[None, :], 0)
    lower = cs[:, start, jnp.arange(POOL_GROUPS)[None, :]]
    count = (pos[:, None] + 1 - start).astype(jnp.float32)
    pooled = (cs[:, 1:] - lower) / count[None, :, :, None]
    return (pooled - a4).astype(a.dtype)


def causal_depthwise_conv(z, w):
    return lax.conv_general_dilated(
        z, w[:, None, :], window_strides=(1,), padding=[(CONV_K - 1, 0)],
        dimension_numbers=('NWC', 'WIO', 'NWC'), feature_group_count=z.shape[-1])


def chunked_spatial_gating(u, v, ln_g, w_s, b_s):
    b, t, _ = u.shape
    n = t // SGU_CHUNK
    vh = v.reshape(b, n, SGU_CHUNK, SGU_HEADS, SGU_HEAD_DIM).astype(jnp.float32)
    mu = jnp.mean(vh, axis=-1, keepdims=True)
    var = jnp.mean(jnp.square(vh - mu), axis=-1, keepdims=True)
    vh = (vh - mu) * lax.rsqrt(var + LN_EPS) * ln_g.reshape(SGU_HEADS, SGU_HEAD_DIM).astype(jnp.float32)
    vh = vh.astype(u.dtype)
    mask = jnp.tril(jnp.ones((SGU_CHUNK, SGU_CHUNK), dtype=bool))
    ws = jnp.where(mask[None], w_s, 0)
    mixed = jnp.einsum('hts,bnshd->bnthd', ws, vh) + b_s.T[None, None, :, :, None]
    return u * mixed.reshape(b, t, SGU_WIDTH)


def setup_inputs(seed: int = 0) -> dict:
    key = jax.random.key(seed)
    ks = jax.random.split(key, 24)
    f32 = jnp.float32
    L, D, F = DEPTH, D_MODEL, D_FF

    def nrm(k, shape, scale):
        return jax.random.normal(k, shape, f32) * scale

    def gain(k, shape):
        return 1.0 + 0.1 * jax.random.normal(k, shape, f32)

    return {
        'x': jax.random.normal(ks[0], (BATCH, SEQ, D), f32),
        'ffn1_norm': gain(ks[1], (L, D)),
        'ffn1_gate': nrm(ks[2], (L, D, F), D ** -0.5),
        'ffn1_up': nrm(ks[3], (L, D, F), D ** -0.5),
        'ffn1_down': nrm(ks[4], (L, F, D), F ** -0.5),
        'mix_norm': gain(ks[5], (L, D)),
        'w_in': nrm(ks[6], (L, D, PROJ_WIDTH), D ** -0.5),
        'pool_w': nrm(ks[7], (L, POOL_GROUPS, POOL_GROUP_DIM, POOL_GROUP_DIM), POOL_GROUP_DIM ** -0.5),
        'pool_scale': gain(ks[8], (L, POOL_WIDTH)),
        'conv_w': nrm(ks[9], (L, CONV_K, CONV_WIDTH), CONV_K ** -0.5),
        'sgu_norm': gain(ks[10], (L, SGU_WIDTH)),
        'sgu_w': nrm(ks[11], (L, SGU_HEADS, SGU_CHUNK, SGU_CHUNK), SGU_CHUNK ** -0.5),
        'sgu_b': gain(ks[12], (L, SGU_HEADS, SGU_CHUNK)),
        'w_out': nrm(ks[13], (L, MIX_WIDTH, D), MIX_WIDTH ** -0.5),
        'ffn2_norm': gain(ks[14], (L, D)),
        'ffn2_gate': nrm(ks[15], (L, D, F), D ** -0.5),
        'ffn2_up': nrm(ks[16], (L, D, F), D ** -0.5),
        'ffn2_down': nrm(ks[17], (L, F, D), F ** -0.5),
        'final_norm': gain(ks[18], (D,)),
    }


def reference(x, ffn1_norm, ffn1_gate, ffn1_up, ffn1_down, mix_norm, w_in, pool_w, pool_scale,
              conv_w, sgu_norm, sgu_w, sgu_b, w_out, ffn2_norm, ffn2_gate, ffn2_up, ffn2_down,
              final_norm):
    b, t, _ = x.shape
    for l in range(DEPTH):
        h = rms_norm(x, ffn1_norm[l])
        x = x + 0.5 * swiglu(h, ffn1_gate[l], ffn1_up[l], ffn1_down[l])

        h = rms_norm(x, mix_norm[l])
        proj = h @ w_in[l]
        a, gb, gc, xc, u, v = jnp.split(proj, list(PROJ_SPLITS), axis=-1)

        pa = causal_multiscale_pool(a)
        ya = jnp.einsum('btgc,gcd->btgd', pa, pool_w[l]).reshape(b, t, POOL_WIDTH) * pool_scale[l]

        yb = gb * causal_depthwise_conv(gc * xc, conv_w[l])

        yc = chunked_spatial_gating(jax.nn.gelu(u), jax.nn.gelu(v), sgu_norm[l], sgu_w[l], sgu_b[l])

        x = x + jnp.concatenate([ya, yb, yc], axis=-1) @ w_out[l]

        h = rms_norm(x, ffn2_norm[l])
        x = x + 0.5 * swiglu(h, ffn2_gate[l], ffn2_up[l], ffn2_down[l])
    return rms_norm(x, final_norm)
```

```cpp
#include <hip/hip_runtime.h>
#include <cstdio>
#include <cstdint>
#include <cstddef>
namespace pg8 {
#define PG8_LAS __attribute__((address_space(3)))
typedef unsigned short bf16_t;
typedef short bf16x8 __attribute__((ext_vector_type(8)));
typedef float f32x4 __attribute__((ext_vector_type(4)));
typedef unsigned u32x4 __attribute__((ext_vector_type(4)));
constexpr int BM = 256, BK = 64, HALF = 128, HTB = HALF * BK * 2  , STAGE_BYTES = 8 * HTB, NXCD = 8, WGM = 8;

__host__ __device__ __forceinline__ int lds_byte(int r, int c) { const int st = (r >> 4) * 2 + (c >> 5), rr = r & 15, cc = c & 31, ob = rr * 64 + cc * 2; return st * 1024 + (ob ^ (((ob >> 9) & 1) << 5)); }
__host__ __device__ __forceinline__ void stage_rc(int b, int& R, int& C) { const int st = b / 1024, sb = b % 1024, swz = sb ^ (((sb >> 9) & 1) << 5); R = (st >> 1) * 16 + swz / 64; C = (st & 1) * 32 + (swz % 64) / 2; }
__host__ __device__ __forceinline__ int perm32(int rho) { const int n = rho >> 4, i = rho & 15; return 8 * (i >> 2) + 4 * n + (i & 3); }

struct Unit { int pm, pn; };
struct Gemm { const bf16_t* A; const bf16_t* Bt; int M, N, K; };

struct StaticOrder {
    int nM, nN, nwg, G, c;
    __host__ __device__ void init(int M, int N, int G_, int c_) { nM = M / BM; nN = N / BM; nwg = nM * nN; G = G_; c = c_; }
    __host__ __device__ bool next(int i, Unit& u) const {
        const long L = (long)i * G + c; if (L >= nwg) return false;
        int wgid = (int)L; { const int q = nwg / NXCD, r = nwg % NXCD, xcd = wgid % NXCD, off = wgid / NXCD; wgid = (xcd < r ? xcd * (q + 1) : r * (q + 1) + (xcd - r) * q) + off; }
        const int nig = WGM * nN, gid = wgid / nig, fm = gid * WGM, gsz = (nM - fm) < WGM ? (nM - fm) : WGM;
        u.pm = fm + ((wgid % nig) % gsz); u.pn = (wgid % nig) / gsz; return true;
    }
    __device__ __forceinline__ void a_ready(const Unit&) const {}
    __device__ __forceinline__ void done(const Unit&) const {}
};
typedef float f32x2 __attribute__((ext_vector_type(2)));
typedef __bf16 bf16x2_t __attribute__((ext_vector_type(2)));
__device__ __forceinline__ unsigned cvt_pk_bf16(float lo, float hi) { const f32x2 v = {lo, hi}; return __builtin_bit_cast(unsigned, __builtin_convertvector(v, bf16x2_t)); }
typedef unsigned u32x2 __attribute__((ext_vector_type(2)));
constexpr int NPART = 16;
__device__ __forceinline__ float row_rstd(const float* part, int row, float inv_d, float eps) {
    const f32x4* p = (const f32x4*)(part + (size_t)row * NPART);
    const f32x4 a = p[0], b = p[1], c = p[2], d = p[3];
    const f32x4 s = (a + b) + (c + d);
    return __builtin_amdgcn_rsqf(((s[0] + s[1]) + (s[2] + s[3])) * inv_d + eps);
}
__device__ __forceinline__ float swiglu1(float g, float u) { const float e = __builtin_amdgcn_exp2f(-1.44269504089f * g); return g * u * __builtin_amdgcn_rcpf(1.0f + e); }

struct EpiSwiglu {
    static constexpr bool PERM = true, AFTER_DRAIN = false;
    bf16_t* H; int ldh; const float* part; float inv_d, eps;
    __device__ __forceinline__ void operator()(const f32x4 (&acc)[2][2][4][2], const Unit& u, int wr, int wc, int fr, int fq) const {
        const int row0 = u.pm * BM + wr * 64 + fr, col0 = u.pn * HALF + wc * 32 + 8 * fq;
#pragma unroll
        for (int ai = 0; ai < 2; ++ai)
#pragma unroll
            for (int m = 0; m < 4; ++m) { const int row = row0 + ai * HALF + m * 16; const float rs = row_rstd(part, row, inv_d, eps);
                const f32x4 g0 = acc[ai][0][m][0] * rs, g1 = acc[ai][0][m][1] * rs, u0 = acc[ai][1][m][0] * rs, u1 = acc[ai][1][m][1] * rs;
                u32x4 w; w.x = cvt_pk_bf16(swiglu1(g0[0], u0[0]), swiglu1(g0[1], u0[1])); w.y = cvt_pk_bf16(swiglu1(g0[2], u0[2]), swiglu1(g0[3], u0[3]));
                w.z = cvt_pk_bf16(swiglu1(g1[0], u1[0]), swiglu1(g1[1], u1[1])); w.w = cvt_pk_bf16(swiglu1(g1[2], u1[2]), swiglu1(g1[3], u1[3]));
                *(u32x4*)(H + (size_t)row * ldh + col0) = w;
                if (m & 1) asm volatile("" ::: "memory"); }
    }
};
struct EpiScaleBf16 {
    static constexpr bool PERM = true, AFTER_DRAIN = false;
    bf16_t* O; int ldo; const float* part; float inv_d, eps;
    __device__ __forceinline__ void operator()(const f32x4 (&acc)[2][2][4][2], const Unit& u, int wr, int wc, int fr, int fq) const {
        const int row0 = u.pm * BM + wr * 64 + fr, col0 = u.pn * BM + wc * 32 + 8 * fq;
#pragma unroll
        for (int ai = 0; ai < 2; ++ai)
#pragma unroll
            for (int m = 0; m < 4; ++m) { const int row = row0 + ai * HALF + m * 16; const float rs = row_rstd(part, row, inv_d, eps);
                bf16_t* rowp = O + (size_t)row * ldo + col0;
#pragma unroll
                for (int bj = 0; bj < 2; ++bj) { const f32x4 v0 = acc[ai][bj][m][0] * rs, v1 = acc[ai][bj][m][1] * rs;
                    u32x4 w; w.x = cvt_pk_bf16(v0[0], v0[1]); w.y = cvt_pk_bf16(v0[2], v0[3]); w.z = cvt_pk_bf16(v1[0], v1[1]); w.w = cvt_pk_bf16(v1[2], v1[3]);
                    *(u32x4*)(rowp + bj * HALF) = w; }
                if (m & 1) asm volatile("" ::: "memory"); }
    }
};
struct EpiResid {
    static constexpr bool PERM = true, AFTER_DRAIN = false;
    const float* Xin; float* Xout; bf16_t* XB; float* part; int ld; float alpha; PG8_LAS float* scr;
    __device__ __forceinline__ void operator()(const f32x4 (&acc)[2][2][4][2], const Unit& u, int wr, int wc, int fr, int fq) const {
        const int row0 = u.pm * BM + wr * 64 + fr, col0 = u.pn * BM + wc * 32 + 8 * fq;
#pragma unroll
        for (int ai = 0; ai < 2; ++ai)
#pragma unroll
            for (int m = 0; m < 4; ++m) { const int row = row0 + ai * HALF + m * 16; const size_t off = (size_t)row * ld + col0; float ss = 0.f;
#pragma unroll
                for (int bj = 0; bj < 2; ++bj) { const f32x4 x0 = *(const f32x4*)(Xin + off + bj * HALF), x1 = *(const f32x4*)(Xin + off + bj * HALF + 4);
                    const f32x4 y0 = x0 + acc[ai][bj][m][0] * alpha, y1 = x1 + acc[ai][bj][m][1] * alpha;
                    *(f32x4*)(Xout + off + bj * HALF) = y0; *(f32x4*)(Xout + off + bj * HALF + 4) = y1;
                    u32x4 w; w.x = cvt_pk_bf16(y0[0], y0[1]); w.y = cvt_pk_bf16(y0[2], y0[3]); w.z = cvt_pk_bf16(y1[0], y1[1]); w.w = cvt_pk_bf16(y1[2], y1[3]);
                    *(u32x4*)(XB + off + bj * HALF) = w;
                    ss += (y0[0] * y0[0] + y0[1] * y0[1]) + (y0[2] * y0[2] + y0[3] * y0[3]) + (y1[0] * y1[0] + y1[1] * y1[1]) + (y1[2] * y1[2] + y1[3] * y1[3]); }
                ss += __shfl_xor(ss, 16); ss += __shfl_xor(ss, 32);
                if (fq == 0) scr[(ai * HALF + wr * 64 + m * 16 + fr) * 4 + wc] = ss;
                if (m & 1) asm volatile("" ::: "memory"); }
        asm volatile("s_waitcnt lgkmcnt(0)" ::: "memory"); __builtin_amdgcn_s_barrier(); asm volatile("" ::: "memory");
        const int lane = fq * 16 + fr;
        if (lane < 32) { const int rl = (wc >> 1) * HALF + wr * 64 + (wc & 1) * 32 + lane;
            const f32x4 v = *(const PG8_LAS f32x4*)(scr + rl * 4);
            part[(size_t)(u.pm * BM + rl) * NPART + u.pn] = (v[0] + v[1]) + (v[2] + v[3]); }
    }
};

template <class Epi, class Sched, bool ALIGN_EPI = false, bool SP2 = false>
__device__ __forceinline__ void gemm_phase(PG8_LAS unsigned char* lds, const Gemm g, const Sched& S, const Epi& E) {
    int tid_ = threadIdx.x; asm volatile("" : "+v"(tid_));
    const int tid = tid_, wid = __builtin_amdgcn_readfirstlane(tid >> 6), lane = tid & 63, wr = wid >> 2, wc = wid & 3, fr = lane & 15, fq = lane >> 4;
    const int K = g.K, nt = K / BK;
    unsigned voffA[2], voffB[2];
#pragma unroll
    for (int i = 0; i < 2; ++i) { int R, C; stage_rc(tid * 16 + i * 8192, R, C); const int Rb = Epi::PERM ? ((R & ~31) + perm32(R & 31)) : R;
        voffA[i] = (unsigned)(R * K + C) * 2u; voffB[i] = (unsigned)(Rb * K + C) * 2u; }
    const size_t kstep = (size_t)(BK * 2);
    const size_t hstep = (size_t)HALF * K * 2;
    const size_t tstep = 2 * hstep;
    const unsigned ldsw = (unsigned)wid * 1024u;
    const int aoff = lds_byte(wr * 64 + fr, fq * 8), boff = lds_byte(wc * 32 + fr, fq * 8);
#define PG8_SA(b, h) (((b) * 2 + (h)) * HTB)
#define PG8_SB(b, h) ((4 + (b) * 2 + (h)) * HTB)
#define PG8_STAGE(bufoff, gbase, voff) do { _Pragma("unroll") for (int _i = 0; _i < 2; ++_i) \
        __builtin_amdgcn_global_load_lds((const unsigned*)((const char*)(gbase) + (voff)[_i]), (PG8_LAS unsigned*)(lds + (bufoff) + ldsw + _i * 8192), 16, 0, 0); } while (0)
#define PG8_LDA(dst, b, h) do { _Pragma("unroll") for (int m = 0; m < 4; ++m) _Pragma("unroll") for (int k = 0; k < 2; ++k) dst[m][k] = *(const PG8_LAS bf16x8*)(lds + PG8_SA(b, h) + aoff + m * 2048 + k * 1024); } while (0)
#define PG8_LDB(dst, b, h) do { _Pragma("unroll") for (int n = 0; n < 2; ++n) _Pragma("unroll") for (int k = 0; k < 2; ++k) dst[n][k] = *(const PG8_LAS bf16x8*)(lds + PG8_SB(b, h) + boff + n * 2048 + k * 1024); } while (0)
#define PG8_MMA(ai, bj, At, Bt) do { __builtin_amdgcn_s_setprio(1); _Pragma("unroll") for (int m = 0; m < 4; ++m) _Pragma("unroll") for (int n = 0; n < 2; ++n) _Pragma("unroll") for (int k = 0; k < 2; ++k) \
        acc[ai][bj][m][n] = __builtin_amdgcn_mfma_f32_16x16x32_bf16(Bt[n][k], At[m][k], acc[ai][bj][m][n], 0, 0, 0); __builtin_amdgcn_s_setprio(0); } while (0)
#define PG8_WAIT_V(n) asm volatile("s_waitcnt vmcnt(" #n ")" ::: "memory")
#define PG8_WAIT_L(n) asm volatile("s_waitcnt lgkmcnt(" #n ")" ::: "memory")
#define PG8_BAR __builtin_amdgcn_s_barrier()
#define PG8_SCHED __builtin_amdgcn_sched_barrier(0)
    Unit cur, nxt; int ui = 0;
    if (!S.next(0, cur)) return;
    f32x4 acc[2][2][4][2];
#pragma unroll
    for (int a = 0; a < 2; ++a)
#pragma unroll
        for (int b = 0; b < 2; ++b)
#pragma unroll
            for (int m = 0; m < 4; ++m)
#pragma unroll
                for (int n = 0; n < 2; ++n) acc[a][b][m][n] = (f32x4){0.f, 0.f, 0.f, 0.f};
    bf16x8 At[4][2], B0[2][2], B1[2][2];
    const char* cA = (const char*)g.A + (size_t)cur.pm * tstep; const char* cB = (const char*)g.Bt + (size_t)cur.pn * tstep;
    S.a_ready(cur);
    if constexpr (SP2) {
        PG8_STAGE(PG8_SB(0, 0), cB, voffB); PG8_STAGE(PG8_SB(0, 1), cB + hstep, voffB); PG8_STAGE(PG8_SA(0, 0), cA, voffA); PG8_STAGE(PG8_SA(0, 1), cA + hstep, voffA);
        if (wr == 1) PG8_BAR;
        PG8_WAIT_V(2); PG8_BAR;
        PG8_STAGE(PG8_SB(1, 0), cB + kstep, voffB); PG8_STAGE(PG8_SA(1, 0), cA + kstep, voffA); PG8_STAGE(PG8_SB(1, 1), cB + hstep + kstep, voffB);
        PG8_WAIT_V(6); PG8_BAR;
    } else {
        PG8_STAGE(PG8_SB(0, 0), cB, voffB); PG8_STAGE(PG8_SA(0, 0), cA, voffA); PG8_STAGE(PG8_SB(0, 1), cB + hstep, voffB); PG8_STAGE(PG8_SA(0, 1), cA + hstep, voffA);
        if (wr == 1) PG8_BAR;
        PG8_WAIT_V(4); PG8_BAR;
        PG8_STAGE(PG8_SB(1, 0), cB + kstep, voffB); PG8_STAGE(PG8_SA(1, 0), cA + kstep, voffA); PG8_STAGE(PG8_SB(1, 1), cB + hstep + kstep, voffB);
        PG8_WAIT_V(6); PG8_BAR;
    }
    for (;;) {
        const bool has_next = S.next(ui + 1, nxt);
        const char* nA = has_next ? (const char*)g.A + (size_t)nxt.pm * tstep : cA; const char* nB = has_next ? (const char*)g.Bt + (size_t)nxt.pn * tstep : cB;
        for (int t = 0; t < nt; t += 2) {
            const bool last = (t == nt - 2);
            const char* a1 = cA + (size_t)(t + 1) * kstep;
            const char* a2 = last ? nA : cA + (size_t)(t + 2) * kstep; const char* b2 = last ? nB : cB + (size_t)(t + 2) * kstep;
            const char* a3 = a2 + kstep; const char* b3 = b2 + kstep;
            if (last && has_next) S.a_ready(nxt);
            if constexpr (SP2) {
            PG8_LDB(B0, 0, 0); PG8_LDB(B1, 0, 1); PG8_SCHED; PG8_LDA(At, 0, 0); PG8_STAGE(PG8_SA(1, 1), a1 + hstep, voffA);
            PG8_WAIT_V(8); PG8_WAIT_L(0); PG8_BAR; PG8_MMA(0, 0, At, B0); PG8_MMA(0, 1, At, B1); PG8_BAR; PG8_SCHED;
            PG8_LDA(At, 0, 1); PG8_STAGE(PG8_SB(0, 0), b2, voffB); PG8_STAGE(PG8_SB(0, 1), b2 + hstep, voffB); PG8_STAGE(PG8_SA(0, 0), a2, voffA);
            PG8_WAIT_V(8); PG8_WAIT_L(0); PG8_BAR; PG8_MMA(1, 0, At, B0); PG8_MMA(1, 1, At, B1); PG8_BAR; PG8_SCHED;
            PG8_LDB(B0, 1, 0); PG8_LDB(B1, 1, 1); PG8_SCHED; PG8_LDA(At, 1, 0); PG8_STAGE(PG8_SA(0, 1), a2 + hstep, voffA);
            PG8_WAIT_V(8); PG8_WAIT_L(0); PG8_BAR; PG8_MMA(0, 0, At, B0); PG8_MMA(0, 1, At, B1); PG8_BAR; PG8_SCHED;
            PG8_LDA(At, 1, 1); PG8_STAGE(PG8_SB(1, 0), b3, voffB); PG8_STAGE(PG8_SB(1, 1), b3 + hstep, voffB); PG8_STAGE(PG8_SA(1, 0), a3, voffA);
            PG8_WAIT_V(8); PG8_WAIT_L(0); PG8_BAR; PG8_MMA(1, 0, At, B0); PG8_MMA(1, 1, At, B1); PG8_BAR; PG8_SCHED;
            } else {
            PG8_LDB(B0, 0, 0); PG8_SCHED; PG8_LDA(At, 0, 0); PG8_STAGE(PG8_SA(1, 1), a1 + hstep, voffA);
            PG8_WAIT_L(8); PG8_BAR; PG8_WAIT_L(0); PG8_MMA(0, 0, At, B0); PG8_BAR; PG8_SCHED;
            PG8_LDB(B1, 0, 1); PG8_STAGE(PG8_SB(0, 0), b2, voffB);
            PG8_BAR; PG8_WAIT_L(0); PG8_MMA(0, 1, At, B1); PG8_BAR;
            PG8_LDA(At, 0, 1); PG8_STAGE(PG8_SA(0, 0), a2, voffA);
            PG8_BAR; PG8_WAIT_L(0); PG8_MMA(1, 0, At, B0); PG8_BAR; PG8_SCHED;
            PG8_STAGE(PG8_SB(0, 1), b2 + hstep, voffB);
            PG8_WAIT_V(6); PG8_BAR; PG8_MMA(1, 1, At, B1); PG8_BAR;
            PG8_LDB(B0, 1, 0); PG8_SCHED; PG8_LDA(At, 1, 0); PG8_STAGE(PG8_SA(0, 1), a2 + hstep, voffA);
            PG8_WAIT_L(8); PG8_BAR; PG8_WAIT_L(0); PG8_MMA(0, 0, At, B0); PG8_BAR; PG8_SCHED;
            PG8_LDB(B1, 1, 1); PG8_STAGE(PG8_SB(1, 0), b3, voffB);
            PG8_BAR; PG8_WAIT_L(0); PG8_MMA(0, 1, At, B1); PG8_BAR;
            PG8_LDA(At, 1, 1); PG8_STAGE(PG8_SA(1, 0), a3, voffA);
            PG8_BAR; PG8_WAIT_L(0); PG8_MMA(1, 0, At, B0); PG8_BAR; PG8_SCHED;
            PG8_STAGE(PG8_SB(1, 1), b3 + hstep, voffB);
            PG8_WAIT_V(6); PG8_BAR; PG8_MMA(1, 1, At, B1); PG8_BAR;
            }
        }
        if constexpr (ALIGN_EPI) { if (wr == 0) PG8_BAR; }
        if constexpr (!Epi::AFTER_DRAIN) { E(acc, cur, wr, wc, fr, fq); S.done(cur); }
        if (!has_next) break;
#pragma unroll
        for (int a = 0; a < 2; ++a)
#pragma unroll
            for (int b = 0; b < 2; ++b)
#pragma unroll
                for (int m = 0; m < 4; ++m)
#pragma unroll
                    for (int n = 0; n < 2; ++n) acc[a][b][m][n] = (f32x4){0.f, 0.f, 0.f, 0.f};
        cur = nxt; cA = nA; cB = nB; ++ui;
        if constexpr (ALIGN_EPI) { if (wr == 1) PG8_BAR; }
    }
    PG8_WAIT_V(0);
    if constexpr (!ALIGN_EPI) { if (wr == 0) PG8_BAR; }
    PG8_BAR;
    if constexpr (Epi::AFTER_DRAIN) { E.fused(acc, cur, wr, wc, fr, fq, lds, wid, lane); S.done(cur); }
#undef PG8_SA
#undef PG8_SB
#undef PG8_STAGE
#undef PG8_LDA
#undef PG8_LDB
#undef PG8_MMA
#undef PG8_WAIT_V
#undef PG8_WAIT_L
#undef PG8_BAR
#undef PG8_SCHED
}
}
#ifndef PG8_SP2
#define PG8_SP2 true
#endif
#ifndef PG8_ALIGN
#define PG8_ALIGN true
#endif
constexpr int NWAVES = 8;
#ifndef MK_DBG
#define MK_DBG 0
#endif
#ifndef MK_DBG_K
#define MK_DBG_K 3
#endif
#ifndef MK_PER_PHASE
#define MK_PER_PHASE 1
#endif

constexpr int BATCH = 4, SEQ = 2048, D = 4096, DEPTH = 4, FF = 5632;
constexpr int M = BATCH * SEQ;
constexpr int POOL_W = 1024, CONV_W = 1536, SGU_W = 1536, PROJ = 8704;
constexpr int C_A = 0, C_GB = 1024, C_GC = 2560, C_XC = 4096, C_U = 5632, C_V = 7168;
constexpr int O_YA = 0, O_YB = 1024, O_YC = 2560;
constexpr float NORM_EPS = 1e-6f, LN_EPS = 1e-5f;
constexpr int NPHASES = 2 + 7 * DEPTH;

constexpr size_t MiB = 1u << 20;
constexpr size_t WS_CTL = 0, CTL_ZERO_BYTES = 1 * MiB;
constexpr size_t SZ_W1 = (size_t)2 * FF * D * 2;
constexpr size_t SZ_WD = (size_t)D * FF * 2;
constexpr size_t SZ_WIN = (size_t)PROJ * D * 2, SZ_WOUT = (size_t)D * D * 2;
constexpr size_t WS_W1 = 2 * MiB;
constexpr size_t WS_WD = WS_W1 + 2 * DEPTH * SZ_W1;
constexpr size_t WS_WIN = WS_WD + 2 * DEPTH * SZ_WD;
constexpr size_t WS_WOUT = WS_WIN + DEPTH * SZ_WIN;
constexpr size_t WS_POOLW = WS_WOUT + DEPTH * SZ_WOUT;
constexpr size_t WS_SGUW = WS_POOLW + (size_t)DEPTH * 4 * 256 * 256 * 2;
constexpr size_t WS_XB = WS_SGUW + (size_t)DEPTH * 12 * 128 * 128 * 2;
constexpr size_t WS_HID = WS_XB + (size_t)M * D * 2;
constexpr size_t WS_PROJ = WS_HID + (size_t)M * FF * 2;
constexpr size_t WS_MIX = WS_PROJ + (size_t)M * PROJ * 2;
constexpr size_t WS_PART = WS_MIX + (size_t)M * D * 2;
constexpr size_t WS_END = WS_PART + (size_t)M * 16 * 4;
static_assert(WS_W1 % 256 == 0 && WS_WD % 256 == 0 && WS_WIN % 256 == 0 && WS_WOUT % 256 == 0 && WS_POOLW % 256 == 0 && WS_SGUW % 256 == 0 && WS_XB % 256 == 0 && WS_HID % 256 == 0 && WS_PROJ % 256 == 0 && WS_MIX % 256 == 0 && WS_PART % 256 == 0, "d_ws map alignment");
constexpr int CW_BAR = 4096;

constexpr int RING_OFF = 0, RING_BYTES = 131072;
constexpr int SCR_OFF = RING_BYTES;
constexpr int LDS_BYTES = 147456;
constexpr int MISC_OFF = LDS_BYTES - 256;
static_assert(SCR_OFF + 4096 <= MISC_OFF, "LDS map");

#define GAS __attribute__((address_space(1)))
#define LAS __attribute__((address_space(3)))
typedef unsigned short bf16;
typedef unsigned v4u __attribute__((ext_vector_type(4)));
typedef float f32x4 __attribute__((ext_vector_type(4)));
typedef short bf16x8 __attribute__((ext_vector_type(8)));
typedef GAS unsigned gu32;
typedef GAS unsigned long long gu64;
#define RLX_AGENT __ATOMIC_RELAXED, __HIP_MEMORY_SCOPE_AGENT
#define LDS_WAIT() asm volatile("s_waitcnt lgkmcnt(0)" ::: "memory")
#define VM_WAIT() asm volatile("s_waitcnt vmcnt(0)" ::: "memory")
__device__ __forceinline__ unsigned long long rt() { return __builtin_amdgcn_s_memrealtime(); }
__device__ __forceinline__ unsigned f2bf(float f) { unsigned u = __builtin_bit_cast(unsigned, f); return (u + 0x7fffu + ((u >> 16) & 1u)) >> 16; }
__device__ __forceinline__ unsigned pk2(float lo, float hi) { return f2bf(lo) | (f2bf(hi) << 16); }
#define XB_TMO      128
#define XB_XCNT(j)  (256  + 64 * (j))
#define XB_XSUB(j)  (1280 + 64 * (j))
#define XB_XGEN(j)  (2304 + 64 * (j))
#define XB_TOP      3328
#define XB_TOPGEN   3392
#define XCD_BAR_WORDS 3456
#define XB_SPIN_CAP (1u << 18)

__device__ __forceinline__ unsigned xb_ld(unsigned* p)              { return __hip_atomic_load(p, __ATOMIC_RELAXED, __HIP_MEMORY_SCOPE_AGENT); }
__device__ __forceinline__ unsigned xb_add(unsigned* p, unsigned v) { return __hip_atomic_fetch_add(p, v, __ATOMIC_RELAXED, __HIP_MEMORY_SCOPE_AGENT); }
__device__ __forceinline__ unsigned xb_xcc_id() { return (unsigned)__builtin_amdgcn_s_getreg((3 << 11) | 20) & 0xFu; }
#define XB_SPIN(cond, bar) do { unsigned _sp = 0; while (cond) { __builtin_amdgcn_s_sleep(1); \
    if ((++_sp & 255u) == 0u) { if (xb_ld(&(bar)[XB_TMO])) break; if (_sp > XB_SPIN_CAP) { atomicAdd(&(bar)[XB_TMO], 1u); break; } } } } while (0)

struct XcdBarrier {
    unsigned* bar; unsigned x;
    volatile LAS unsigned* st;
};

__device__ __forceinline__ XcdBarrier xcd_barrier_post(unsigned* bar, volatile LAS unsigned* st) {
    XcdBarrier b; b.bar = bar; b.x = xb_xcc_id(); b.st = st;
    if (threadIdx.x == 0) (void)xb_add(&bar[XB_XCNT(b.x)], 1u);
    return b;
}
__device__ __forceinline__ void xcd_barrier_complete(unsigned* bar, unsigned x, unsigned& nloc, unsigned& nx) {
    const unsigned G = gridDim.x * gridDim.y * gridDim.z;
    unsigned sum, cnt, mine, sp = 0u;
    for (;;) {
        sum = 0u; cnt = 0u; mine = 0u;
#pragma unroll
        for (unsigned j = 0; j < 16; ++j) { const unsigned c = xb_ld(&bar[XB_XCNT(j)]); sum += c; cnt += (c > 0u) ? 1u : 0u; mine = (j == x) ? c : mine; }
        if (sum == G) break;
        __builtin_amdgcn_s_sleep(1);
        if ((++sp & 255u) == 0u) { if (xb_ld(&bar[XB_TMO])) break; if (sp > XB_SPIN_CAP) { atomicAdd(&bar[XB_TMO], 1u); break; } }
    }
    nloc = mine > 0u ? mine : 1u; nx = cnt > 0u ? cnt : 1u;
}

__device__ __forceinline__ void xcd_barrier(const XcdBarrier& b) {
    asm volatile("s_waitcnt vmcnt(0)" ::: "memory");
    __syncthreads();
    if (threadIdx.x == 0) {
        unsigned* bar = b.bar;
        __builtin_amdgcn_s_waitcnt(0);
        unsigned nloc = b.st[0], nx = b.st[1];
        if (nloc == 0u) { xcd_barrier_complete(bar, b.x, nloc, nx); b.st[0] = nloc; b.st[1] = nx; }
        const unsigned old = xb_add(&bar[XB_XSUB(b.x)], 1u);
        const unsigned gen = old / nloc;
        if (old + 1u == (gen + 1u) * nloc) {
            __builtin_amdgcn_fence(__ATOMIC_RELEASE, "agent");
            asm volatile("s_waitcnt vmcnt(0)" ::: "memory");
            const unsigned og = xb_add(&bar[XB_TOP], 1u);
            const unsigned tg = og / nx;
            if (og + 1u == (tg + 1u) * nx) xb_add(&bar[XB_TOPGEN], 1u);
            else XB_SPIN(xb_ld(&bar[XB_TOPGEN]) == tg, bar);
            __builtin_amdgcn_fence(__ATOMIC_ACQUIRE, "agent");
            xb_add(&bar[XB_XGEN(b.x)], 1u);
            asm volatile("s_waitcnt vmcnt(0)" ::: "memory");
        } else {
            XB_SPIN(xb_ld(&bar[XB_XGEN(b.x)]) == gen, bar);
            __builtin_amdgcn_fence(__ATOMIC_ACQUIRE, "agent");
            asm volatile("s_waitcnt vmcnt(0)" ::: "memory");
        }
    }
    __syncthreads();
}
struct Frame {
    LAS unsigned char* lds;
    volatile LAS unsigned* MISC;
    gu32* ctl;
    int tid, lane, wave;
    int vcu, G;
    const float* in[19];
    float* X;
    bf16 *W1T, *WDT, *WINT, *WOUTT, *POOLWT, *SGUWB;
    bf16 *XB, *HID, *PRJ, *MIX; float* PART;
};
__device__ __forceinline__ float wave_sum(float v) {
#pragma unroll
    for (int o = 1; o < 64; o <<= 1) v += __shfl_xor(v, o);
    return v;
}
__device__ __forceinline__ unsigned cvtpk(float lo, float hi) { return pg8::cvt_pk_bf16(lo, hi); }
__device__ __forceinline__ float bflo(unsigned w) { return __builtin_bit_cast(float, w << 16); }
__device__ __forceinline__ float bfhi(unsigned w) { return __builtin_bit_cast(float, w & 0xffff0000u); }
__device__ __forceinline__ float gelu_tanh(float x) {
    const float y = 0.7978845608028654f * (x + 0.044715f * x * x * x);
    const float e = __builtin_amdgcn_exp2f(-2.8853900817779268f * y);
    return x * __builtin_amdgcn_rcpf(1.0f + e);
}

__device__ __forceinline__ void tr_item(const float* W, int N, int K, const float* gk, bf16* Bt, int k0, int n0, int nrow0, LAS float* T, int lane) {
    const int kq = lane >> 4, nq = lane & 15;
    f32x4 v[16];
#pragma unroll
    for (int i = 0; i < 16; ++i) v[i] = *(const GAS f32x4*)(W + (size_t)(k0 + 4 * i + kq) * N + n0 + 4 * nq);
#pragma unroll
    for (int i = 0; i < 16; ++i) { const int kk = 4 * i + kq; const float s = gk ? gk[k0 + kk] : 1.0f;
        T[(4 * nq + 0) * 65 + kk] = v[i][0] * s; T[(4 * nq + 1) * 65 + kk] = v[i][1] * s; T[(4 * nq + 2) * 65 + kk] = v[i][2] * s; T[(4 * nq + 3) * 65 + kk] = v[i][3] * s; }
    LDS_WAIT(); asm volatile("" ::: "memory");
    const int c = lane & 7;
#pragma unroll
    for (int j = 0; j < 8; ++j) { const int n = (lane >> 3) + 8 * j; const LAS float* s = T + n * 65 + 8 * c;
        v4u o; o.x = cvtpk(s[0], s[1]); o.y = cvtpk(s[2], s[3]); o.z = cvtpk(s[4], s[5]); o.w = cvtpk(s[6], s[7]);
        *(GAS v4u*)(Bt + (size_t)(nrow0 + n) * K + k0 + 8 * c) = o; }
    LDS_WAIT(); asm volatile("" ::: "memory");
}
__device__ __forceinline__ void p0_prologue(Frame& F) {
    LAS float* T = (LAS float*)(F.lds + F.wave * 16640);
    const int gw = F.vcu * NWAVES + F.wave, NGW = F.G * NWAVES;
    constexpr int I_GU = (D / 64) * (FF / 64), I_DN = (FF / 64) * (D / 64), I_IN = (D / 64) * (PROJ / 64), I_OUT = (D / 64) * (D / 64);
    constexpr int PER_LAYER = 6 * I_GU + I_IN + I_OUT;
    static_assert(I_GU == I_DN, "item counts");
    for (int it = gw; it < DEPTH * PER_LAYER; it += NGW) {
        const int l = it / PER_LAYER; int r = it - l * PER_LAYER;
        const int ffn = (r >= 3 * I_GU + I_IN + I_OUT) ? 1 : 0;
        if (ffn) r -= 3 * I_GU + I_IN + I_OUT;
        if (r < 3 * I_GU) {
            const float* gate = (ffn ? F.in[15] : F.in[2]) + (size_t)l * D * FF; const float* up = (ffn ? F.in[16] : F.in[3]) + (size_t)l * D * FF; const float* down = (ffn ? F.in[17] : F.in[4]) + (size_t)l * FF * D;
            const float* gk = (ffn ? F.in[14] : F.in[1]) + (size_t)l * D;
            bf16* w1t = F.W1T + (size_t)(l * 2 + ffn) * (2 * FF) * D; bf16* wdt = F.WDT + (size_t)(l * 2 + ffn) * D * FF;
            if (r < 2 * I_GU) { const int isup = r >= I_GU; if (isup) r -= I_GU; const int kb = r / (FF / 64), nb = r % (FF / 64), n0 = nb * 64;
                tr_item(isup ? up : gate, FF, D, gk, w1t, kb * 64, n0, (n0 >> 7) * 256 + (n0 & 127) + (isup ? 128 : 0), T, F.lane); }
            else { r -= 2 * I_GU; const int kb = r / (D / 64), nb = r % (D / 64); tr_item(down, D, FF, nullptr, wdt, kb * 64, nb * 64, nb * 64, T, F.lane); }
        } else { r -= 3 * I_GU;
            if (r < I_IN) { const int kb = r / (PROJ / 64), nb = r % (PROJ / 64); tr_item(F.in[6] + (size_t)l * D * PROJ, PROJ, D, F.in[5] + (size_t)l * D, F.WINT + (size_t)l * PROJ * D, kb * 64, nb * 64, nb * 64, T, F.lane); }
            else { r -= I_IN; const int kb = r / (D / 64), nb = r % (D / 64); tr_item(F.in[13] + (size_t)l * D * D, D, D, nullptr, F.WOUTT + (size_t)l * D * D, kb * 64, nb * 64, nb * 64, T, F.lane); }
        }
    }
    const int gt = F.vcu * (NWAVES * 64) + F.tid, NGT = F.G * NWAVES * 64;
    for (int i = gt; i < DEPTH * 4 * 256 * 32; i += NGT) { const int c8 = i & 31, d = (i >> 5) & 255, lg = i >> 13;
        const float* src = F.in[7] + ((size_t)lg * 256 + 8 * c8) * 256 + d; const float sc = F.in[8][(size_t)lg * 256 + d];
        v4u o; o.x = cvtpk(src[0 * 256] * sc, src[1 * 256] * sc); o.y = cvtpk(src[2 * 256] * sc, src[3 * 256] * sc); o.z = cvtpk(src[4 * 256] * sc, src[5 * 256] * sc); o.w = cvtpk(src[6 * 256] * sc, src[7 * 256] * sc);
        *(GAS v4u*)(F.POOLWT + ((size_t)lg * 256 + d) * 256 + 8 * c8) = o; }
    for (int i = gt; i < DEPTH * 12 * 128 * 16; i += NGT) { const int s8 = i & 15, t = (i >> 4) & 127; const float* src = F.in[11] + (size_t)i * 8; float w[8];
#pragma unroll
        for (int j = 0; j < 8; ++j) w[j] = (8 * s8 + j <= t) ? src[j] : 0.f;
        v4u o; o.x = cvtpk(w[0], w[1]); o.y = cvtpk(w[2], w[3]); o.z = cvtpk(w[4], w[5]); o.w = cvtpk(w[6], w[7]);
        *(GAS v4u*)(F.SGUWB + (size_t)i * 8) = o; }
    for (int m = gw; m < M; m += NGW) { const GAS f32x4* xr = (const GAS f32x4*)(F.in[0] + (size_t)m * D) + F.lane; float ss = 0.f;
        GAS unsigned long long* o8 = (GAS unsigned long long*)(F.XB + (size_t)m * D) + F.lane;
#pragma unroll
        for (int j = 0; j < 16; ++j) { const f32x4 v = xr[64 * j]; ss += (v.x * v.x + v.y * v.y) + (v.z * v.z + v.w * v.w);
            o8[64 * j] = (unsigned long long)cvtpk(v.x, v.y) | ((unsigned long long)cvtpk(v.z, v.w) << 32); }
        ss = wave_sum(ss);
        if (F.lane < 16) F.PART[(size_t)m * 16 + F.lane] = (F.lane == 0) ? ss : 0.f; }
}

template <int W> __device__ __forceinline__ void pool_window(Frame& F, const bf16* prj, int R0, int g, LAS unsigned char* PA) {
    const int c8 = F.tid & 31, seg = F.tid >> 5, t0 = seg * 8;
    const int tl0 = (R0 & (SEQ - 1)) + t0;
    const bf16* src = prj + (size_t)(R0 + t0) * PROJ + C_A + g * 256 + c8 * 8;
    v4u rows[8 + W - 1];
#pragma unroll
    for (int i = 0; i < 8 + W - 1; ++i) { const int dt = i - (W - 1); rows[i] = (tl0 + dt >= 0) ? *(const GAS v4u*)(src + (ptrdiff_t)dt * PROJ) : (v4u){0u, 0u, 0u, 0u}; }
    float S[8];
#pragma unroll
    for (int j = 0; j < 8; ++j) S[j] = 0.f;
#pragma unroll
    for (int i = 0; i < W - 1; ++i) { const v4u r = rows[i]; S[0] += bflo(r.x); S[1] += bfhi(r.x); S[2] += bflo(r.y); S[3] += bfhi(r.y); S[4] += bflo(r.z); S[5] += bfhi(r.z); S[6] += bflo(r.w); S[7] += bfhi(r.w); }
#pragma unroll
    for (int t = 0; t < 8; ++t) { const v4u r = rows[t + W - 1];
        const float a[8] = {bflo(r.x), bfhi(r.x), bflo(r.y), bfhi(r.y), bflo(r.z), bfhi(r.z), bflo(r.w), bfhi(r.w)};
#pragma unroll
        for (int j = 0; j < 8; ++j) S[j] += a[j];
        const int cnt = (tl0 + t + 1 < W) ? (tl0 + t + 1) : W; const float ic = 1.0f / (float)cnt;
        v4u o; o.x = cvtpk(S[0] * ic - a[0], S[1] * ic - a[1]); o.y = cvtpk(S[2] * ic - a[2], S[3] * ic - a[3]); o.z = cvtpk(S[4] * ic - a[4], S[5] * ic - a[5]); o.w = cvtpk(S[6] * ic - a[6], S[7] * ic - a[7]);
        *(LAS v4u*)(PA + (t0 + t) * 528 + c8 * 16) = o;
        const v4u q = rows[t];
        S[0] -= bflo(q.x); S[1] -= bfhi(q.x); S[2] -= bflo(q.y); S[3] -= bfhi(q.y); S[4] -= bflo(q.z); S[5] -= bfhi(q.z); S[6] -= bflo(q.w); S[7] -= bfhi(q.w); }
}
__device__ __forceinline__ void pool_unit(Frame& F, int l, int ck, int g) {
    LAS unsigned char* PA = F.lds;
    const int R0 = ck * 128;
    if (g == 0) pool_window<2>(F, F.PRJ, R0, g, PA); else if (g == 1) pool_window<4>(F, F.PRJ, R0, g, PA); else if (g == 2) pool_window<8>(F, F.PRJ, R0, g, PA); else pool_window<16>(F, F.PRJ, R0, g, PA);
    __syncthreads();
    const int fr = F.lane & 15, fq = F.lane >> 4, w = F.wave;
    bf16x8 af[8];
#pragma unroll
    for (int kk = 0; kk < 8; ++kk) af[kk] = *(const LAS bf16x8*)(PA + (16 * w + fr) * 528 + kk * 64 + fq * 16);
    const bf16* Wt = F.POOLWT + (size_t)(l * 4 + g) * 256 * 256;
    bf16* orow = F.MIX + (size_t)(R0 + 16 * w + fr) * D + O_YA + g * 256 + 4 * fq;
#pragma unroll 4
    for (int n = 0; n < 16; ++n) { f32x4 acc = {0.f, 0.f, 0.f, 0.f}; const bf16* wp = Wt + (size_t)(16 * n + fr) * 256 + fq * 8;
#pragma unroll
        for (int kk = 0; kk < 8; ++kk) { const bf16x8 b = *(const GAS bf16x8*)(wp + kk * 32); acc = __builtin_amdgcn_mfma_f32_16x16x32_bf16(b, af[kk], acc, 0, 0, 0); }
        unsigned long long o = (unsigned long long)cvtpk(acc[0], acc[1]) | ((unsigned long long)cvtpk(acc[2], acc[3]) << 32);
        *(GAS unsigned long long*)(orow + 16 * n) = o; }
    __syncthreads();
}
__device__ __forceinline__ void sgu_unit(Frame& F, int l, int ck, int h) {
    LAS unsigned char* VT = F.lds + 69632;
    const int R0 = ck * 128;
    { const int s = F.tid >> 2, q = F.tid & 3;
        const bf16* src = F.PRJ + (size_t)(R0 + s) * PROJ + C_V + h * 128 + q * 32; float x[32];
#pragma unroll
        for (int i = 0; i < 4; ++i) { const v4u r = *(const GAS v4u*)(src + 8 * i);
            x[8 * i + 0] = gelu_tanh(bflo(r.x)); x[8 * i + 1] = gelu_tanh(bfhi(r.x)); x[8 * i + 2] = gelu_tanh(bflo(r.y)); x[8 * i + 3] = gelu_tanh(bfhi(r.y));
            x[8 * i + 4] = gelu_tanh(bflo(r.z)); x[8 * i + 5] = gelu_tanh(bfhi(r.z)); x[8 * i + 6] = gelu_tanh(bflo(r.w)); x[8 * i + 7] = gelu_tanh(bfhi(r.w)); }
        float sm = 0.f;
#pragma unroll
        for (int i = 0; i < 32; ++i) sm += x[i];
        sm += __shfl_xor(sm, 1); sm += __shfl_xor(sm, 2);
        const float mu = sm * (1.0f / 128.0f); float sq = 0.f;
#pragma unroll
        for (int i = 0; i < 32; ++i) { x[i] -= mu; sq += x[i] * x[i]; }
        sq += __shfl_xor(sq, 1); sq += __shfl_xor(sq, 2);
        const float rstd = __builtin_amdgcn_rsqf(sq * (1.0f / 128.0f) + LN_EPS);
        const float* lg = F.in[10] + (size_t)l * SGU_W + h * 128 + q * 32;
#pragma unroll
        for (int i = 0; i < 32; ++i) { const float y = x[i] * rstd * lg[i]; *(LAS unsigned short*)(VT + (q * 32 + i) * 272 + s * 2) = (unsigned short)(cvtpk(y, y) & 0xffffu); }
    }
    __syncthreads();
    const int fr = F.lane & 15, fq = F.lane >> 4, w = F.wave;
    const bf16* ws = F.SGUWB + ((size_t)(l * 12 + h) * 128 + 16 * w + fr) * 128 + fq * 8;
    f32x4 acc[8];
#pragma unroll
    for (int n = 0; n < 8; ++n) acc[n] = (f32x4){0.f, 0.f, 0.f, 0.f};
    const int nk = (16 * w + 15) / 32 + 1;
#pragma unroll
    for (int kk = 0; kk < 4; ++kk) if (kk < nk) { const bf16x8 a = *(const GAS bf16x8*)(ws + kk * 32);
#pragma unroll
        for (int n = 0; n < 8; ++n) { const bf16x8 b = *(const LAS bf16x8*)(VT + (16 * n + fr) * 272 + kk * 64 + fq * 16); acc[n] = __builtin_amdgcn_mfma_f32_16x16x32_bf16(b, a, acc[n], 0, 0, 0); } }
    const int t = 16 * w + fr; const float bias = F.in[12][(size_t)(l * 12 + h) * 128 + t];
    const bf16* up = F.PRJ + (size_t)(R0 + t) * PROJ + C_U + h * 128 + 4 * fq; bf16* op = F.MIX + (size_t)(R0 + t) * D + O_YC + h * 128 + 4 * fq;
#pragma unroll
    for (int n = 0; n < 8; ++n) { const unsigned long long uu = *(const GAS unsigned long long*)(up + 16 * n); const unsigned u0 = (unsigned)uu, u1 = (unsigned)(uu >> 32);
        const float y0 = gelu_tanh(bflo(u0)) * (acc[n][0] + bias), y1 = gelu_tanh(bfhi(u0)) * (acc[n][1] + bias), y2 = gelu_tanh(bflo(u1)) * (acc[n][2] + bias), y3 = gelu_tanh(bfhi(u1)) * (acc[n][3] + bias);
        *(GAS unsigned long long*)(op + 16 * n) = (unsigned long long)cvtpk(y0, y1) | ((unsigned long long)cvtpk(y2, y3) << 32); }
    __syncthreads();
}
__device__ __forceinline__ void mixer_phase(Frame& F, int l) {
    const int b = F.vcu;
    for (int u = b; u < (M / 128) * 4; u += F.G) pool_unit(F, l, u >> 2, u & 3);
    for (int u = b; u < (M / 128) * 12; u += F.G) sgu_unit(F, l, u / 12, u % 12);
    const float* cw = F.in[9] + (size_t)l * 3 * CONV_W;
    const int gt = b * (NWAVES * 64) + F.tid, NGT = F.G * NWAVES * 64;
    for (int i = gt; i < M * (CONV_W / 8); i += NGT) { const int row = i / (CONV_W / 8), c = (i - row * (CONV_W / 8)) * 8, tl = row & (SEQ - 1);
        const bf16* p = F.PRJ + (size_t)row * PROJ + c;
        const v4u gb = *(const GAS v4u*)(p + C_GB), g0 = *(const GAS v4u*)(p + C_GC), x0 = *(const GAS v4u*)(p + C_XC);
        v4u g1 = {0u, 0u, 0u, 0u}, x1 = g1, g2 = g1, x2 = g1;
        if (tl >= 1) { g1 = *(const GAS v4u*)(p - PROJ + C_GC); x1 = *(const GAS v4u*)(p - PROJ + C_XC); }
        if (tl >= 2) { g2 = *(const GAS v4u*)(p - 2 * PROJ + C_GC); x2 = *(const GAS v4u*)(p - 2 * PROJ + C_XC); }
        const unsigned gbw[4] = {gb.x, gb.y, gb.z, gb.w}, g0w[4] = {g0.x, g0.y, g0.z, g0.w}, x0w[4] = {x0.x, x0.y, x0.z, x0.w}, g1w[4] = {g1.x, g1.y, g1.z, g1.w}, x1w[4] = {x1.x, x1.y, x1.z, x1.w}, g2w[4] = {g2.x, g2.y, g2.z, g2.w}, x2w[4] = {x2.x, x2.y, x2.z, x2.w};
        unsigned ow[4];
#pragma unroll
        for (int j = 0; j < 4; ++j) {
            const float w0a = cw[c + 2 * j], w0b = cw[c + 2 * j + 1], w1a = cw[CONV_W + c + 2 * j], w1b = cw[CONV_W + c + 2 * j + 1], w2a = cw[2 * CONV_W + c + 2 * j], w2b = cw[2 * CONV_W + c + 2 * j + 1];
            const float ya = bflo(gbw[j]) * (w0a * (bflo(g2w[j]) * bflo(x2w[j])) + w1a * (bflo(g1w[j]) * bflo(x1w[j])) + w2a * (bflo(g0w[j]) * bflo(x0w[j])));
            const float yb = bfhi(gbw[j]) * (w0b * (bfhi(g2w[j]) * bfhi(x2w[j])) + w1b * (bfhi(g1w[j]) * bfhi(x1w[j])) + w2b * (bfhi(g0w[j]) * bfhi(x0w[j])));
            ow[j] = cvtpk(ya, yb); }
        *(GAS v4u*)(F.MIX + (size_t)row * D + O_YB + c) = (v4u){ow[0], ow[1], ow[2], ow[3]}; }
}
__device__ __forceinline__ void final_norm(Frame& F) {
    const int gw = F.vcu * NWAVES + F.wave, NGW = F.G * NWAVES; const GAS f32x4* gn = (const GAS f32x4*)F.in[18] + F.lane;
    for (int m = gw; m < M; m += NGW) { GAS f32x4* xr = (GAS f32x4*)(F.X + (size_t)m * D) + F.lane; f32x4 v[16]; float ss = 0.f;
#pragma unroll
        for (int j = 0; j < 16; ++j) { v[j] = xr[64 * j]; ss += (v[j].x * v[j].x + v[j].y * v[j].y) + (v[j].z * v[j].z + v[j].w * v[j].w); }
        const float rs = 1.0f / sqrtf(wave_sum(ss) * (1.0f / D) + NORM_EPS);
#pragma unroll
        for (int j = 0; j < 16; ++j) xr[64 * j] = v[j] * rs * gn[64 * j]; }
}

struct Args { const float* in[19]; float* out; unsigned char* ws; int ph_lo, ph_hi; };
static_assert(sizeof(Args) == 21 * 8 + 8, "Args has no holes");
__global__ void __launch_bounds__(NWAVES * 64, 2) mk_fwd(Args args) {
    extern __shared__ __attribute__((aligned(16))) unsigned char lds[];
    Frame F;
    F.lds = (LAS unsigned char*)lds;
    F.MISC = (volatile LAS unsigned*)(F.lds + MISC_OFF);
    F.tid = threadIdx.x; F.lane = F.tid & 63; F.wave = __builtin_amdgcn_readfirstlane(F.tid >> 6);
    F.G = gridDim.x; { const int bx = blockIdx.x; F.vcu = (F.G % 8 == 0) ? (bx % 8) * (F.G / 8) + bx / 8 : bx; }
    unsigned char* ws = args.ws;
    F.ctl = (gu32*)(ws + WS_CTL);
#pragma unroll
    for (int i = 0; i < 19; ++i) F.in[i] = args.in[i];
    F.X = args.out;
    F.W1T = (bf16*)(ws + WS_W1); F.WDT = (bf16*)(ws + WS_WD); F.WINT = (bf16*)(ws + WS_WIN); F.WOUTT = (bf16*)(ws + WS_WOUT); F.POOLWT = (bf16*)(ws + WS_POOLW); F.SGUWB = (bf16*)(ws + WS_SGUW);
    F.XB = (bf16*)(ws + WS_XB); F.HID = (bf16*)(ws + WS_HID); F.PRJ = (bf16*)(ws + WS_PROJ); F.MIX = (bf16*)(ws + WS_MIX); F.PART = (float*)(ws + WS_PART);
    if (F.tid < 64) ((LAS unsigned*)(F.lds + MISC_OFF))[F.tid] = 0u;
    __syncthreads();
    XcdBarrier bar = xcd_barrier_post((unsigned*)(F.ctl + CW_BAR), F.MISC + 8);
    const int lo = args.ph_lo, hi = args.ph_hi;
#define IN(k) (lo <= (k) && (k) < hi)
#define SEAM(k) do { if (IN(k) && IN((k) + 1)) xcd_barrier(bar); } while (0)
    LAS float* scr = (LAS float*)(F.lds + SCR_OFF);

#if MK_DBG == 2
    if (lo == -2) {
        const size_t gt = (size_t)blockIdx.x * (NWAVES * 64) + F.tid, NGT = (size_t)F.G * NWAVES * 64; unsigned mask = 0u;
        for (size_t i = gt; i < (size_t)DEPTH * 4 * 256 * 256; i += NGT) { const float v = bflo((unsigned)F.POOLWT[i]); if (!(__builtin_fabsf(v) < 1e30f)) mask |= 1u; }
        for (size_t i = gt; i < (size_t)DEPTH * 12 * 128 * 128; i += NGT) { const float v = bflo((unsigned)F.SGUWB[i]); if (!(__builtin_fabsf(v) < 1e30f)) mask |= 2u; }
        if (MK_DBG_K >= 5) for (size_t i = gt; i < (size_t)M * D; i += NGT) { const float v = bflo((unsigned)F.MIX[i]); const int c = (int)(i & (D - 1)); if (!(__builtin_fabsf(v) < 1e30f)) mask |= (c < 1024 ? 4u : c < 2560 ? 16u : 32u); }
        for (size_t i = gt; i < (size_t)M * D; i += NGT) if (!(__builtin_fabsf(F.X[i]) < 1e30f)) mask |= 8u;
        if (mask) atomicOr((unsigned*)(F.ctl + 16), mask);
        return; }
    if (lo == -1) {
        const unsigned mask = __hip_atomic_load(F.ctl + 16, RLX_AGENT); const int gw = F.vcu * NWAVES + F.wave, NGW = F.G * NWAVES;
        for (int m = gw; m < M; m += NGW) { const GAS f32x4* xr = (const GAS f32x4*)(F.in[0] + (size_t)m * D) + F.lane; GAS f32x4* o = (GAS f32x4*)(F.X + (size_t)m * D) + F.lane;
            for (int j = 0; j < 16; ++j) { f32x4 v = xr[64 * j]; if (m == 0 && j == 0 && F.lane == 0) v[0] = 100.f * (float)mask; o[64 * j] = v; } }
        return; }
#endif
    if (IN(0)) p0_prologue(F);
    SEAM(0);
    int ph = 1;
    for (int s = 0; s < 2 * DEPTH; ++s) {
        const int l = s >> 1, second = s & 1;
        const bf16* xb = F.XB; const bf16* hid = F.HID; const bf16* mix = F.MIX; int cblk = (int)blockIdx.x;
        asm volatile("" : "+s"(xb), "+s"(hid), "+s"(mix), "+s"(cblk));
        asm volatile("" : "+v"(F.tid), "+v"(F.lane), "+s"(F.wave), "+s"(F.vcu));
        if (IN(ph)) { pg8::Gemm g{xb, F.W1T + (size_t)s * (2 * FF) * D, M, 2 * FF, D}; pg8::StaticOrder S; S.init(M, 2 * FF, F.G, cblk);
            pg8::EpiSwiglu E{F.HID, FF, F.PART, 1.0f / D, NORM_EPS};
            pg8::gemm_phase<pg8::EpiSwiglu, pg8::StaticOrder, PG8_ALIGN, PG8_SP2>(F.lds + RING_OFF, g, S, E); }
        SEAM(ph); ++ph;
        if (IN(ph)) { pg8::Gemm g{hid, F.WDT + (size_t)s * D * FF, M, D, FF}; pg8::StaticOrder S; S.init(M, D, F.G, cblk);
            pg8::EpiResid E{(s == 0) ? F.in[0] : (const float*)F.X, F.X, F.XB, F.PART, D, 0.5f, scr};
            pg8::gemm_phase<pg8::EpiResid, pg8::StaticOrder, PG8_ALIGN, PG8_SP2>(F.lds + RING_OFF, g, S, E); }
        SEAM(ph); ++ph;
        if (!second) {
            if (IN(ph)) { pg8::Gemm g{xb, F.WINT + (size_t)l * PROJ * D, M, PROJ, D}; pg8::StaticOrder S; S.init(M, PROJ, F.G, cblk);
                pg8::EpiScaleBf16 E{F.PRJ, PROJ, F.PART, 1.0f / D, NORM_EPS};
                pg8::gemm_phase<pg8::EpiScaleBf16, pg8::StaticOrder, PG8_ALIGN, PG8_SP2>(F.lds + RING_OFF, g, S, E); }
            SEAM(ph); ++ph;
            if (IN(ph)) mixer_phase(F, l);
            SEAM(ph); ++ph;
            if (IN(ph)) { pg8::Gemm g{mix, F.WOUTT + (size_t)l * D * D, M, D, D}; pg8::StaticOrder S; S.init(M, D, F.G, cblk);
                pg8::EpiResid E{F.X, F.X, F.XB, F.PART, D, 1.0f, scr};
                pg8::gemm_phase<pg8::EpiResid, pg8::StaticOrder, PG8_ALIGN, PG8_SP2>(F.lds + RING_OFF, g, S, E); }
            SEAM(ph); ++ph;
        }
    }
#if MK_DBG == 1
    if (IN(ph)) { const int gw = F.vcu * NWAVES + F.wave, NGW = F.G * NWAVES; for (int m = gw; m < M; m += NGW) { const GAS f32x4* xr = (const GAS f32x4*)(F.in[0] + (size_t)m * D) + F.lane; GAS f32x4* o = (GAS f32x4*)(F.X + (size_t)m * D) + F.lane;
        for (int j = 0; j < 16; ++j) o[64 * j] = xr[64 * j]; } }
#elif MK_DBG == 2
    if (IN(ph)) { const int gw = F.vcu * NWAVES + F.wave, NGW = F.G * NWAVES; for (int m = gw; m < M; m += NGW) { GAS f32x4* o = (GAS f32x4*)(F.X + (size_t)m * D) + F.lane;
        for (int j = 0; j < 16; ++j) { f32x4 v = o[64 * j]; bool bad = false; for (int e = 0; e < 4; ++e) if (!(__builtin_fabsf(v[e]) < 1e30f)) { v[e] = 5000.f; bad = true; } if (bad) o[64 * j] = v; } } }
#else
    if (IN(ph)) final_norm(F);
#endif
#undef IN
#undef SEAM
}

extern "C" void kernel_launch(void* const* d_in, const int* in_sizes, int n_in, void* d_out, int out_size, void* d_ws, size_t ws_size, hipStream_t stream) {
    static int grid = 0;
    if (grid == 0) {
        if (n_in != 19 || in_sizes[0] != M * D || out_size != M * D || ws_size < WS_END) { fprintf(stderr, "kernel_launch: built for 19 inputs, x and out of %d floats, >= %zu bytes of workspace; got n_in %d, in0 %d, out %d, ws %zu; nothing launched\n", M * D, (size_t)WS_END, n_in, n_in > 0 ? in_sizes[0] : -1, out_size, ws_size); grid = -1; return; }
        int dev = 0, cus = 0, per_cu = 0;
        if (hipGetDevice(&dev) != hipSuccess || hipDeviceGetAttribute(&cus, hipDeviceAttributeMultiprocessorCount, dev) != hipSuccess) { fprintf(stderr, "kernel_launch: hipGetDevice / hipDeviceGetAttribute failed; nothing launched\n"); grid = -1; return; }
        if (hipFuncSetAttribute((const void*)mk_fwd, hipFuncAttributeMaxDynamicSharedMemorySize, LDS_BYTES) != hipSuccess) { fprintf(stderr, "kernel_launch: hipFuncSetAttribute failed\n"); grid = -1; return; }
        if (hipOccupancyMaxActiveBlocksPerMultiprocessor(&per_cu, (const void*)mk_fwd, NWAVES * 64, LDS_BYTES) != hipSuccess || per_cu < 1) fprintf(stderr, "kernel_launch: note: occupancy query reports %d workgroups per CU; launching one per CU anyway\n", per_cu);
        (void)hipGetLastError();
        grid = cus;
    }
    if (grid < 0) return;
    if (hipMemsetAsync((char*)d_ws + WS_CTL, 0, CTL_ZERO_BYTES, stream) != hipSuccess) { fprintf(stderr, "kernel_launch: hipMemsetAsync of the control words failed; nothing launched\n"); return; }
    Args a{};
    for (int i = 0; i < 19; ++i) a.in[i] = (const float*)d_in[i];
    a.out = (float*)d_out; a.ws = (unsigned char*)d_ws;
#if MK_DBG == 1
    a.ph_lo = 0; a.ph_hi = 1; hipLaunchKernelGGL(mk_fwd, dim3(grid), dim3(NWAVES * 64), LDS_BYTES, stream, a);
    a.ph_lo = NPHASES - 1; a.ph_hi = NPHASES; hipLaunchKernelGGL(mk_fwd, dim3(grid), dim3(NWAVES * 64), LDS_BYTES, stream, a);
#elif MK_DBG == 2
    for (int p = 0; p < MK_DBG_K; ++p) { a.ph_lo = p; a.ph_hi = p + 1; hipLaunchKernelGGL(mk_fwd, dim3(grid), dim3(NWAVES * 64), LDS_BYTES, stream, a); }
    a.ph_lo = -2; a.ph_hi = -2; hipLaunchKernelGGL(mk_fwd, dim3(grid), dim3(NWAVES * 64), LDS_BYTES, stream, a);
    a.ph_lo = -1; a.ph_hi = -1; hipLaunchKernelGGL(mk_fwd, dim3(grid), dim3(NWAVES * 64), LDS_BYTES, stream, a);
#elif MK_PER_PHASE
    for (int p = 0; p < NPHASES; ++p) { a.ph_lo = p; a.ph_hi = p + 1; hipLaunchKernelGGL(mk_fwd, dim3(grid), dim3(NWAVES * 64), LDS_BYTES, stream, a); }
#else
    a.ph_lo = 0; a.ph_hi = NPHASES;
    hipLaunchKernelGGL(mk_fwd, dim3(grid), dim3(NWAVES * 64), LDS_BYTES, stream, a);
#endif
    const hipError_t le = hipPeekAtLastError();
    if (le != hipSuccess) fprintf(stderr, "kernel_launch: launch failed: %s (grid %d x %d threads, %d B LDS)\n", hipGetErrorName(le), grid, NWAVES * 64, LDS_BYTES);
}
```

```cpp
#include <hip/hip_runtime.h>
#include <cstdio>
#include <cstdint>
#include <cstddef>
namespace pg8 {
#define PG8_LAS __attribute__((address_space(3)))
typedef unsigned short bf16_t;
typedef short bf16x8 __attribute__((ext_vector_type(8)));
typedef float f32x4 __attribute__((ext_vector_type(4)));
typedef unsigned u32x4 __attribute__((ext_vector_type(4)));
constexpr int BM = 256, BK = 64, HALF = 128, HTB = HALF * BK * 2  , STAGE_BYTES = 8 * HTB, NXCD = 8, WGM = 8;

__host__ __device__ __forceinline__ int lds_byte(int r, int c) { const int st = (r >> 4) * 2 + (c >> 5), rr = r & 15, cc = c & 31, ob = rr * 64 + cc * 2; return st * 1024 + (ob ^ (((ob >> 9) & 1) << 5)); }
__host__ __device__ __forceinline__ void stage_rc(int b, int& R, int& C) { const int st = b / 1024, sb = b % 1024, swz = sb ^ (((sb >> 9) & 1) << 5); R = (st >> 1) * 16 + swz / 64; C = (st & 1) * 32 + (swz % 64) / 2; }
__host__ __device__ __forceinline__ int perm32(int rho) { const int n = rho >> 4, i = rho & 15; return 8 * (i >> 2) + 4 * n + (i & 3); }

struct Unit { int pm, pn; };
struct Gemm { const bf16_t* A; const bf16_t* Bt; int M, N, K; };

struct StaticOrder {
    int nM, nN, nwg, G, c;
    __host__ __device__ void init(int M, int N, int G_, int c_) { nM = M / BM; nN = N / BM; nwg = nM * nN; G = G_; c = c_; }
    __host__ __device__ bool next(int i, Unit& u) const {
        const long L = (long)i * G + c; if (L >= nwg) return false;
        int wgid = (int)L; { const int q = nwg / NXCD, r = nwg % NXCD, xcd = wgid % NXCD, off = wgid / NXCD; wgid = (xcd < r ? xcd * (q + 1) : r * (q + 1) + (xcd - r) * q) + off; }
        const int nig = WGM * nN, gid = wgid / nig, fm = gid * WGM, gsz = (nM - fm) < WGM ? (nM - fm) : WGM;
        u.pm = fm + ((wgid % nig) % gsz); u.pn = (wgid % nig) / gsz; return true;
    }
    __device__ __forceinline__ void a_ready(const Unit&) const {}
    __device__ __forceinline__ void done(const Unit&) const {}
};
typedef float f32x2 __attribute__((ext_vector_type(2)));
typedef __bf16 bf16x2_t __attribute__((ext_vector_type(2)));
__device__ __forceinline__ unsigned cvt_pk_bf16(float lo, float hi) { const f32x2 v = {lo, hi}; return __builtin_bit_cast(unsigned, __builtin_convertvector(v, bf16x2_t)); }
typedef unsigned u32x2 __attribute__((ext_vector_type(2)));
constexpr int NPART = 16;
__device__ __forceinline__ float row_rstd(const float* part, int row, float inv_d, float eps) {
    const f32x4* p = (const f32x4*)(part + (size_t)row * NPART);
    const f32x4 a = p[0], b = p[1], c = p[2], d = p[3];
    const f32x4 s = (a + b) + (c + d);
    return __builtin_amdgcn_rsqf(((s[0] + s[1]) + (s[2] + s[3])) * inv_d + eps);
}
__device__ __forceinline__ float swiglu1(float g, float u) { const float e = __builtin_amdgcn_exp2f(-1.44269504089f * g); return g * u * __builtin_amdgcn_rcpf(1.0f + e); }

struct EpiSwiglu {
    static constexpr bool PERM = true, AFTER_DRAIN = false;
    bf16_t* H; int ldh; const float* part; float inv_d, eps; const PG8_LAS float* rtab; int pm0;
    __device__ __forceinline__ void operator()(const f32x4 (&acc)[2][2][4][2], const Unit& u, int wr, int wc, int fr, int fq) const {
        const int row0 = u.pm * BM + wr * 64 + fr, col0 = u.pn * HALF + wc * 32 + 8 * fq;
#pragma unroll
        for (int ai = 0; ai < 2; ++ai)
#pragma unroll
            for (int m = 0; m < 4; ++m) { const int row = row0 + ai * HALF + m * 16; const float rs = (u.pm == pm0) ? rtab[ai * HALF + wr * 64 + m * 16 + fr] : row_rstd(part, row, inv_d, eps);
                const f32x4 g0 = acc[ai][0][m][0] * rs, g1 = acc[ai][0][m][1] * rs, u0 = acc[ai][1][m][0] * rs, u1 = acc[ai][1][m][1] * rs;
                u32x4 w; w.x = cvt_pk_bf16(swiglu1(g0[0], u0[0]), swiglu1(g0[1], u0[1])); w.y = cvt_pk_bf16(swiglu1(g0[2], u0[2]), swiglu1(g0[3], u0[3]));
                w.z = cvt_pk_bf16(swiglu1(g1[0], u1[0]), swiglu1(g1[1], u1[1])); w.w = cvt_pk_bf16(swiglu1(g1[2], u1[2]), swiglu1(g1[3], u1[3]));
                *(u32x4*)(H + (size_t)row * ldh + col0) = w;
                if (m & 1) asm volatile("" ::: "memory"); }
    }
};
struct EpiScaleBf16 {
    static constexpr bool PERM = true, AFTER_DRAIN = false;
    bf16_t* O; int ldo; const float* part; float inv_d, eps; const PG8_LAS float* rtab; int pm0;
    __device__ __forceinline__ void operator()(const f32x4 (&acc)[2][2][4][2], const Unit& u, int wr, int wc, int fr, int fq) const {
        const int row0 = u.pm * BM + wr * 64 + fr, col0 = u.pn * BM + wc * 32 + 8 * fq;
#pragma unroll
        for (int ai = 0; ai < 2; ++ai)
#pragma unroll
            for (int m = 0; m < 4; ++m) { const int row = row0 + ai * HALF + m * 16; const float rs = (u.pm == pm0) ? rtab[ai * HALF + wr * 64 + m * 16 + fr] : row_rstd(part, row, inv_d, eps);
                bf16_t* rowp = O + (size_t)row * ldo + col0;
#pragma unroll
                for (int bj = 0; bj < 2; ++bj) { const f32x4 v0 = acc[ai][bj][m][0] * rs, v1 = acc[ai][bj][m][1] * rs;
                    u32x4 w; w.x = cvt_pk_bf16(v0[0], v0[1]); w.y = cvt_pk_bf16(v0[2], v0[3]); w.z = cvt_pk_bf16(v1[0], v1[1]); w.w = cvt_pk_bf16(v1[2], v1[3]);
                    *(u32x4*)(rowp + bj * HALF) = w; }
                if (m & 1) asm volatile("" ::: "memory"); }
    }
};
__device__ __forceinline__ float bf_lo(unsigned w) { return __builtin_bit_cast(float, w << 16); }
__device__ __forceinline__ float bf_hi(unsigned w) { return __builtin_bit_cast(float, w & 0xffff0000u); }
struct EpiResid {
    static constexpr bool PERM = true, AFTER_DRAIN = false;
    bf16_t* XB; float* part; int ld; float alpha; PG8_LAS float* scr;
    __device__ __forceinline__ void operator()(const f32x4 (&acc)[2][2][4][2], const Unit& u, int wr, int wc, int fr, int fq) const {
        const int row0 = u.pm * BM + wr * 64 + fr, col0 = u.pn * BM + wc * 32 + 8 * fq;
        u32x4 xin[2][4][2];
#pragma unroll
        for (int ai = 0; ai < 2; ++ai)
#pragma unroll
            for (int m = 0; m < 4; ++m)
#pragma unroll
                for (int bj = 0; bj < 2; ++bj) xin[ai][m][bj] = *(const u32x4*)(XB + (size_t)(row0 + ai * HALF + m * 16) * ld + col0 + bj * HALF);
#pragma unroll
        for (int ai = 0; ai < 2; ++ai)
#pragma unroll
            for (int m = 0; m < 4; ++m) { const size_t off = (size_t)(row0 + ai * HALF + m * 16) * ld + col0; float ss = 0.f;
#pragma unroll
                for (int bj = 0; bj < 2; ++bj) { const u32x4 x = xin[ai][m][bj]; const f32x4 a0 = acc[ai][bj][m][0] * alpha, a1 = acc[ai][bj][m][1] * alpha;
                    u32x4 w; w.x = cvt_pk_bf16(bf_lo(x.x) + a0[0], bf_hi(x.x) + a0[1]); w.y = cvt_pk_bf16(bf_lo(x.y) + a0[2], bf_hi(x.y) + a0[3]);
                    w.z = cvt_pk_bf16(bf_lo(x.z) + a1[0], bf_hi(x.z) + a1[1]); w.w = cvt_pk_bf16(bf_lo(x.w) + a1[2], bf_hi(x.w) + a1[3]);
                    *(u32x4*)(XB + off + bj * HALF) = w;
                    const float r0 = bf_lo(w.x), r1 = bf_hi(w.x), r2 = bf_lo(w.y), r3 = bf_hi(w.y), r4 = bf_lo(w.z), r5 = bf_hi(w.z), r6 = bf_lo(w.w), r7 = bf_hi(w.w);
                    ss += ((r0 * r0 + r1 * r1) + (r2 * r2 + r3 * r3)) + ((r4 * r4 + r5 * r5) + (r6 * r6 + r7 * r7)); }
                ss += __shfl_xor(ss, 16); ss += __shfl_xor(ss, 32);
                if (fq == 0) scr[(ai * HALF + wr * 64 + m * 16 + fr) * 4 + wc] = ss; }
        asm volatile("s_waitcnt lgkmcnt(0)" ::: "memory"); __builtin_amdgcn_s_barrier(); asm volatile("" ::: "memory");
        const int lane = fq * 16 + fr;
        if (lane < 32) { const int rl = (wc >> 1) * HALF + wr * 64 + (wc & 1) * 32 + lane;
            const f32x4 v = *(const PG8_LAS f32x4*)(scr + rl * 4);
            part[(size_t)(u.pm * BM + rl) * NPART + u.pn] = (v[0] + v[1]) + (v[2] + v[3]); }
    }
};

template <class Epi, class Sched, bool ALIGN_EPI = false, bool SP2 = false>
__device__ __forceinline__ void gemm_phase(PG8_LAS unsigned char* lds, const Gemm g, const Sched& S, const Epi& E) {
    int tid_ = threadIdx.x; asm volatile("" : "+v"(tid_));
    const int tid = tid_, wid = __builtin_amdgcn_readfirstlane(tid >> 6), lane = tid & 63, wr = wid >> 2, wc = wid & 3, fr = lane & 15, fq = lane >> 4;
    const int K = g.K, nt = K / BK;
    unsigned voffA[2], voffB[2];
#pragma unroll
    for (int i = 0; i < 2; ++i) { int R, C; stage_rc(tid * 16 + i * 8192, R, C); const int Rb = Epi::PERM ? ((R & ~31) + perm32(R & 31)) : R;
        voffA[i] = (unsigned)(R * K + C) * 2u; voffB[i] = (unsigned)(Rb * K + C) * 2u; }
    const size_t kstep = (size_t)(BK * 2);
    const size_t hstep = (size_t)HALF * K * 2;
    const size_t tstep = 2 * hstep;
    const unsigned ldsw = (unsigned)wid * 1024u;
    const int aoff = lds_byte(wr * 64 + fr, fq * 8), boff = lds_byte(wc * 32 + fr, fq * 8);
#define PG8_SA(b, h) (((b) * 2 + (h)) * HTB)
#define PG8_SB(b, h) ((4 + (b) * 2 + (h)) * HTB)
#define PG8_STAGE(bufoff, gbase, voff) do { _Pragma("unroll") for (int _i = 0; _i < 2; ++_i) \
        __builtin_amdgcn_global_load_lds((const unsigned*)((const char*)(gbase) + (voff)[_i]), (PG8_LAS unsigned*)(lds + (bufoff) + ldsw + _i * 8192), 16, 0, 0); } while (0)
#define PG8_LDA(dst, b, h) do { _Pragma("unroll") for (int m = 0; m < 4; ++m) _Pragma("unroll") for (int k = 0; k < 2; ++k) dst[m][k] = *(const PG8_LAS bf16x8*)(lds + PG8_SA(b, h) + aoff + m * 2048 + k * 1024); } while (0)
#define PG8_LDB(dst, b, h) do { _Pragma("unroll") for (int n = 0; n < 2; ++n) _Pragma("unroll") for (int k = 0; k < 2; ++k) dst[n][k] = *(const PG8_LAS bf16x8*)(lds + PG8_SB(b, h) + boff + n * 2048 + k * 1024); } while (0)
#define PG8_MMA(ai, bj, At, Bt) do { __builtin_amdgcn_s_setprio(1); _Pragma("unroll") for (int m = 0; m < 4; ++m) _Pragma("unroll") for (int n = 0; n < 2; ++n) _Pragma("unroll") for (int k = 0; k < 2; ++k) \
        acc[ai][bj][m][n] = __builtin_amdgcn_mfma_f32_16x16x32_bf16(Bt[n][k], At[m][k], acc[ai][bj][m][n], 0, 0, 0); __builtin_amdgcn_s_setprio(0); } while (0)
#define PG8_WAIT_V(n) asm volatile("s_waitcnt vmcnt(" #n ")" ::: "memory")
#define PG8_WAIT_L(n) asm volatile("s_waitcnt lgkmcnt(" #n ")" ::: "memory")
#define PG8_BAR __builtin_amdgcn_s_barrier()
#define PG8_SCHED __builtin_amdgcn_sched_barrier(0)
    Unit cur, nxt; int ui = 0;
    if (!S.next(0, cur)) return;
    f32x4 acc[2][2][4][2];
#pragma unroll
    for (int a = 0; a < 2; ++a)
#pragma unroll
        for (int b = 0; b < 2; ++b)
#pragma unroll
            for (int m = 0; m < 4; ++m)
#pragma unroll
                for (int n = 0; n < 2; ++n) acc[a][b][m][n] = (f32x4){0.f, 0.f, 0.f, 0.f};
    bf16x8 At[4][2], B0[2][2], B1[2][2];
    const char* cA = (const char*)g.A + (size_t)cur.pm * tstep; const char* cB = (const char*)g.Bt + (size_t)cur.pn * tstep;
    S.a_ready(cur);
    if constexpr (SP2) {
        PG8_STAGE(PG8_SB(0, 0), cB, voffB); PG8_STAGE(PG8_SB(0, 1), cB + hstep, voffB); PG8_STAGE(PG8_SA(0, 0), cA, voffA); PG8_STAGE(PG8_SA(0, 1), cA + hstep, voffA);
        if (wr == 1) PG8_BAR;
        PG8_WAIT_V(2); PG8_BAR;
        PG8_STAGE(PG8_SB(1, 0), cB + kstep, voffB); PG8_STAGE(PG8_SA(1, 0), cA + kstep, voffA); PG8_STAGE(PG8_SB(1, 1), cB + hstep + kstep, voffB);
        PG8_WAIT_V(6); PG8_BAR;
    } else {
        PG8_STAGE(PG8_SB(0, 0), cB, voffB); PG8_STAGE(PG8_SA(0, 0), cA, voffA); PG8_STAGE(PG8_SB(0, 1), cB + hstep, voffB); PG8_STAGE(PG8_SA(0, 1), cA + hstep, voffA);
        if (wr == 1) PG8_BAR;
        PG8_WAIT_V(4); PG8_BAR;
        PG8_STAGE(PG8_SB(1, 0), cB + kstep, voffB); PG8_STAGE(PG8_SA(1, 0), cA + kstep, voffA); PG8_STAGE(PG8_SB(1, 1), cB + hstep + kstep, voffB);
        PG8_WAIT_V(6); PG8_BAR;
    }
    for (;;) {
        const bool has_next = S.next(ui + 1, nxt);
        const char* nA = has_next ? (const char*)g.A + (size_t)nxt.pm * tstep : cA + (size_t)(nt - 2) * kstep; const char* nB = has_next ? (const char*)g.Bt + (size_t)nxt.pn * tstep : cB + (size_t)(nt - 2) * kstep;
        for (int t = 0; t < nt; t += 2) {
            const bool last = (t == nt - 2);
            const char* a1 = cA + (size_t)(t + 1) * kstep;
            const char* a2 = last ? nA : cA + (size_t)(t + 2) * kstep; const char* b2 = last ? nB : cB + (size_t)(t + 2) * kstep;
            const char* a3 = a2 + kstep; const char* b3 = b2 + kstep;
            if (last && has_next) S.a_ready(nxt);
            if constexpr (SP2) {
            PG8_LDB(B0, 0, 0); PG8_LDB(B1, 0, 1); PG8_SCHED; PG8_LDA(At, 0, 0); PG8_STAGE(PG8_SA(1, 1), a1 + hstep, voffA);
            PG8_WAIT_V(8); PG8_WAIT_L(0); PG8_BAR; PG8_MMA(0, 0, At, B0); PG8_MMA(0, 1, At, B1); PG8_BAR; PG8_SCHED;
            PG8_LDA(At, 0, 1); PG8_STAGE(PG8_SB(0, 0), b2, voffB); PG8_STAGE(PG8_SB(0, 1), b2 + hstep, voffB); PG8_STAGE(PG8_SA(0, 0), a2, voffA);
            PG8_WAIT_V(8); PG8_WAIT_L(0); PG8_BAR; PG8_MMA(1, 0, At, B0); PG8_MMA(1, 1, At, B1); PG8_BAR; PG8_SCHED;
            PG8_LDB(B0, 1, 0); PG8_LDB(B1, 1, 1); PG8_SCHED; PG8_LDA(At, 1, 0); PG8_STAGE(PG8_SA(0, 1), a2 + hstep, voffA);
            PG8_WAIT_V(8); PG8_WAIT_L(0); PG8_BAR; PG8_MMA(0, 0, At, B0); PG8_MMA(0, 1, At, B1); PG8_BAR; PG8_SCHED;
            PG8_LDA(At, 1, 1); PG8_STAGE(PG8_SB(1, 0), b3, voffB); PG8_STAGE(PG8_SB(1, 1), b3 + hstep, voffB); PG8_STAGE(PG8_SA(1, 0), a3, voffA);
            PG8_WAIT_V(8); PG8_WAIT_L(0); PG8_BAR; PG8_MMA(1, 0, At, B0); PG8_MMA(1, 1, At, B1); PG8_BAR; PG8_SCHED;
            } else {
            PG8_LDB(B0, 0, 0); PG8_SCHED; PG8_LDA(At, 0, 0); PG8_STAGE(PG8_SA(1, 1), a1 + hstep, voffA);
            PG8_WAIT_L(8); PG8_BAR; PG8_WAIT_L(0); PG8_MMA(0, 0, At, B0); PG8_BAR; PG8_SCHED;
            PG8_LDB(B1, 0, 1); PG8_STAGE(PG8_SB(0, 0), b2, voffB);
            PG8_BAR; PG8_WAIT_L(0); PG8_MMA(0, 1, At, B1); PG8_BAR;
            PG8_LDA(At, 0, 1); PG8_STAGE(PG8_SA(0, 0), a2, voffA);
            PG8_BAR; PG8_WAIT_L(0); PG8_MMA(1, 0, At, B0); PG8_BAR; PG8_SCHED;
            PG8_STAGE(PG8_SB(0, 1), b2 + hstep, voffB);
            PG8_WAIT_V(6); PG8_BAR; PG8_MMA(1, 1, At, B1); PG8_BAR;
            PG8_LDB(B0, 1, 0); PG8_SCHED; PG8_LDA(At, 1, 0); PG8_STAGE(PG8_SA(0, 1), a2 + hstep, voffA);
            PG8_WAIT_L(8); PG8_BAR; PG8_WAIT_L(0); PG8_MMA(0, 0, At, B0); PG8_BAR; PG8_SCHED;
            PG8_LDB(B1, 1, 1); PG8_STAGE(PG8_SB(1, 0), b3, voffB);
            PG8_BAR; PG8_WAIT_L(0); PG8_MMA(0, 1, At, B1); PG8_BAR;
            PG8_LDA(At, 1, 1); PG8_STAGE(PG8_SA(1, 0), a3, voffA);
            PG8_BAR; PG8_WAIT_L(0); PG8_MMA(1, 0, At, B0); PG8_BAR; PG8_SCHED;
            PG8_STAGE(PG8_SB(1, 1), b3 + hstep, voffB);
            PG8_WAIT_V(6); PG8_BAR; PG8_MMA(1, 1, At, B1); PG8_BAR;
            }
        }
        if constexpr (ALIGN_EPI) { if (wr == 0) PG8_BAR; }
        if constexpr (!Epi::AFTER_DRAIN) { E(acc, cur, wr, wc, fr, fq); S.done(cur); }
        if (!has_next) break;
#pragma unroll
        for (int a = 0; a < 2; ++a)
#pragma unroll
            for (int b = 0; b < 2; ++b)
#pragma unroll
                for (int m = 0; m < 4; ++m)
#pragma unroll
                    for (int n = 0; n < 2; ++n) acc[a][b][m][n] = (f32x4){0.f, 0.f, 0.f, 0.f};
        cur = nxt; cA = nA; cB = nB; ++ui;
        if constexpr (ALIGN_EPI) { if (wr == 1) PG8_BAR; }
    }
    PG8_WAIT_V(0);
    if constexpr (!ALIGN_EPI) { if (wr == 0) PG8_BAR; }
    PG8_BAR;
    if constexpr (Epi::AFTER_DRAIN) { E.fused(acc, cur, wr, wc, fr, fq, lds, wid, lane); S.done(cur); }
#undef PG8_SA
#undef PG8_SB
#undef PG8_STAGE
#undef PG8_LDA
#undef PG8_LDB
#undef PG8_MMA
#undef PG8_WAIT_V
#undef PG8_WAIT_L
#undef PG8_BAR
#undef PG8_SCHED
}
}
#ifndef PG8_SP2
#define PG8_SP2 true
#endif
#ifndef PG8_ALIGN
#define PG8_ALIGN true
#endif
constexpr int NWAVES = 8;
#ifndef MK_TAILFILL
#define MK_TAILFILL 1
#endif
#ifndef MK_PER_PHASE
#define MK_PER_PHASE 0
#endif

constexpr int BATCH = 4, SEQ = 2048, D = 4096, DEPTH = 4, FF = 5632;
constexpr int M = BATCH * SEQ;
constexpr int POOL_W = 1024, CONV_W = 1536, SGU_W = 1536, PROJ = 8704;
constexpr int C_A = 0, C_GB = 1024, C_GC = 2560, C_XC = 4096, C_U = 5632, C_V = 7168;
constexpr int O_YA = 0, O_YB = 1024, O_YC = 2560;
constexpr float NORM_EPS = 1e-6f, LN_EPS = 1e-5f;
constexpr int NPHASES = 2 + 7 * DEPTH;

constexpr size_t MiB = 1u << 20;
constexpr size_t WS_CTL = 0, CTL_ZERO_BYTES = 1 * MiB;
constexpr size_t SZ_W1 = (size_t)2 * FF * D * 2;
constexpr size_t SZ_WD = (size_t)D * FF * 2;
constexpr size_t SZ_WIN = (size_t)PROJ * D * 2, SZ_WOUT = (size_t)D * D * 2;
constexpr size_t WS_W1 = 2 * MiB;
constexpr size_t WS_WD = WS_W1 + 2 * DEPTH * SZ_W1;
constexpr size_t WS_WIN = WS_WD + 2 * DEPTH * SZ_WD;
constexpr size_t WS_WOUT = WS_WIN + DEPTH * SZ_WIN;
constexpr size_t WS_POOLW = WS_WOUT + DEPTH * SZ_WOUT;
constexpr size_t WS_SGUW = WS_POOLW + (size_t)DEPTH * 4 * 256 * 256 * 2;
constexpr size_t WS_XB = WS_SGUW + (size_t)DEPTH * 12 * 128 * 128 * 2;
constexpr size_t WS_HID = WS_XB + (size_t)M * D * 2;
constexpr size_t WS_PROJ = WS_HID + (size_t)M * FF * 2;
constexpr size_t WS_MIX = WS_PROJ + (size_t)M * PROJ * 2;
constexpr size_t WS_PART = WS_MIX + (size_t)M * D * 2;
constexpr size_t WS_END = WS_PART + (size_t)M * 16 * 4;
static_assert(WS_W1 % 256 == 0 && WS_WD % 256 == 0 && WS_WIN % 256 == 0 && WS_WOUT % 256 == 0 && WS_POOLW % 256 == 0 && WS_SGUW % 256 == 0 && WS_XB % 256 == 0 && WS_HID % 256 == 0 && WS_PROJ % 256 == 0 && WS_MIX % 256 == 0 && WS_PART % 256 == 0, "d_ws map alignment");
constexpr int CW_BAR = 4096;

constexpr int RING_OFF = 0, RING_BYTES = 131072;
constexpr int SCR_OFF = RING_BYTES;
constexpr int LDS_BYTES = 147456;
constexpr int MISC_OFF = LDS_BYTES - 256;
static_assert(SCR_OFF + 4096 <= MISC_OFF, "LDS map");

#define GAS __attribute__((address_space(1)))
#define LAS __attribute__((address_space(3)))
typedef unsigned short bf16;
typedef unsigned v4u __attribute__((ext_vector_type(4)));
typedef float f32x4 __attribute__((ext_vector_type(4)));
typedef short bf16x8 __attribute__((ext_vector_type(8)));
typedef GAS unsigned gu32;
typedef GAS unsigned long long gu64;
#define RLX_AGENT __ATOMIC_RELAXED, __HIP_MEMORY_SCOPE_AGENT
#define LDS_WAIT() asm volatile("s_waitcnt lgkmcnt(0)" ::: "memory")
#define VM_WAIT() asm volatile("s_waitcnt vmcnt(0)" ::: "memory")
__device__ __forceinline__ unsigned long long rt() { return __builtin_amdgcn_s_memrealtime(); }
__device__ __forceinline__ unsigned f2bf(float f) { unsigned u = __builtin_bit_cast(unsigned, f); return (u + 0x7fffu + ((u >> 16) & 1u)) >> 16; }
__device__ __forceinline__ unsigned pk2(float lo, float hi) { return f2bf(lo) | (f2bf(hi) << 16); }
#define XB_TMO      128
#define XB_XCNT(j)  (256  + 64 * (j))
#define XB_XSUB(j)  (1280 + 64 * (j))
#define XB_XGEN(j)  (2304 + 64 * (j))
#define XB_TOP      3328
#define XB_TOPGEN   3392
#define XCD_BAR_WORDS 3456
#define XB_SPIN_CAP (1u << 18)

__device__ __forceinline__ unsigned xb_ld(unsigned* p)              { return __hip_atomic_load(p, __ATOMIC_RELAXED, __HIP_MEMORY_SCOPE_AGENT); }
__device__ __forceinline__ unsigned xb_add(unsigned* p, unsigned v) { return __hip_atomic_fetch_add(p, v, __ATOMIC_RELAXED, __HIP_MEMORY_SCOPE_AGENT); }
__device__ __forceinline__ unsigned xb_xcc_id() { return (unsigned)__builtin_amdgcn_s_getreg((3 << 11) | 20) & 0xFu; }
#define XB_SPIN(cond, bar) do { unsigned _sp = 0; while (cond) { __builtin_amdgcn_s_sleep(1); \
    if ((++_sp & 255u) == 0u) { if (xb_ld(&(bar)[XB_TMO])) break; if (_sp > XB_SPIN_CAP) { atomicAdd(&(bar)[XB_TMO], 1u); break; } } } } while (0)

struct XcdBarrier {
    unsigned* bar; unsigned x;
    volatile LAS unsigned* st;
};

__device__ __forceinline__ XcdBarrier xcd_barrier_post(unsigned* bar, volatile LAS unsigned* st) {
    XcdBarrier b; b.bar = bar; b.x = xb_xcc_id(); b.st = st;
    if (threadIdx.x == 0) (void)xb_add(&bar[XB_XCNT(b.x)], 1u);
    return b;
}
__device__ __forceinline__ void xcd_barrier_complete(unsigned* bar, unsigned x, unsigned& nloc, unsigned& nx) {
    const unsigned G = gridDim.x * gridDim.y * gridDim.z;
    unsigned sum, cnt, mine, sp = 0u;
    for (;;) {
        sum = 0u; cnt = 0u; mine = 0u;
#pragma unroll
        for (unsigned j = 0; j < 16; ++j) { const unsigned c = xb_ld(&bar[XB_XCNT(j)]); sum += c; cnt += (c > 0u) ? 1u : 0u; mine = (j == x) ? c : mine; }
        if (sum == G) break;
        __builtin_amdgcn_s_sleep(1);
        if ((++sp & 255u) == 0u) { if (xb_ld(&bar[XB_TMO])) break; if (sp > XB_SPIN_CAP) { atomicAdd(&bar[XB_TMO], 1u); break; } }
    }
    nloc = mine > 0u ? mine : 1u; nx = cnt > 0u ? cnt : 1u;
}

__device__ __forceinline__ void xcd_barrier(const XcdBarrier& b) {
    asm volatile("s_waitcnt vmcnt(0)" ::: "memory");
    __syncthreads();
    if (threadIdx.x == 0) {
        unsigned* bar = b.bar;
        __builtin_amdgcn_s_waitcnt(0);
        unsigned nloc = b.st[0], nx = b.st[1];
        if (nloc == 0u) { xcd_barrier_complete(bar, b.x, nloc, nx); b.st[0] = nloc; b.st[1] = nx; }
        const unsigned old = xb_add(&bar[XB_XSUB(b.x)], 1u);
        const unsigned gen = old / nloc;
        if (old + 1u == (gen + 1u) * nloc) {
            __builtin_amdgcn_fence(__ATOMIC_RELEASE, "agent");
            asm volatile("s_waitcnt vmcnt(0)" ::: "memory");
            const unsigned og = xb_add(&bar[XB_TOP], 1u);
            const unsigned tg = og / nx;
            if (og + 1u == (tg + 1u) * nx) xb_add(&bar[XB_TOPGEN], 1u);
            else XB_SPIN(xb_ld(&bar[XB_TOPGEN]) == tg, bar);
            __builtin_amdgcn_fence(__ATOMIC_ACQUIRE, "agent");
            xb_add(&bar[XB_XGEN(b.x)], 1u);
            asm volatile("s_waitcnt vmcnt(0)" ::: "memory");
        } else {
            XB_SPIN(xb_ld(&bar[XB_XGEN(b.x)]) == gen, bar);
            __builtin_amdgcn_fence(__ATOMIC_ACQUIRE, "agent");
            asm volatile("s_waitcnt vmcnt(0)" ::: "memory");
        }
    }
    __syncthreads();
}
struct Frame {
    LAS unsigned char* lds;
    volatile LAS unsigned* MISC;
    gu32* ctl;
    int tid, lane, wave;
    int vcu, G;
    const float* in[19];
    float* X;
    bf16 *W1T, *WDT, *WINT, *WOUTT, *POOLWT, *SGUWB;
    bf16 *XB, *HID, *PRJ, *MIX; float* PART;
};
__device__ __forceinline__ float wave_sum(float v) {
#pragma unroll
    for (int o = 1; o < 64; o <<= 1) v += __shfl_xor(v, o);
    return v;
}
__device__ __forceinline__ unsigned cvtpk(float lo, float hi) { return pg8::cvt_pk_bf16(lo, hi); }
__device__ __forceinline__ float bflo(unsigned w) { return __builtin_bit_cast(float, w << 16); }
__device__ __forceinline__ float bfhi(unsigned w) { return __builtin_bit_cast(float, w & 0xffff0000u); }
__device__ __forceinline__ float gelu_tanh(float x) {
    const float y = 0.7978845608028654f * (x + 0.044715f * x * x * x);
    const float e = __builtin_amdgcn_exp2f(-2.8853900817779268f * y);
    return x * __builtin_amdgcn_rcpf(1.0f + e);
}

constexpr int I_GU = (D / 64) * (FF / 64), I_DN = (FF / 64) * (D / 64), I_IN = (D / 64) * (PROJ / 64), I_OUT = (D / 64) * (D / 64);
constexpr int PER_LAYER = 6 * I_GU + I_IN + I_OUT;
static_assert(I_GU == I_DN, "item counts");
__device__ __forceinline__ void tr_decode(Frame& F, int l, int it, const float*& W, const float*& gk, bf16*& Bt, int& N, int& K, int& k0, int& n0, int& nrow0) {
    int r = it;
    const int ffn = (r >= 3 * I_GU + I_IN + I_OUT) ? 1 : 0;
    if (ffn) r -= 3 * I_GU + I_IN + I_OUT;
    const float* const gate = (ffn ? F.in[15] : F.in[2]) + (size_t)l * D * FF; const float* const up = (ffn ? F.in[16] : F.in[3]) + (size_t)l * D * FF; const float* const down = (ffn ? F.in[17] : F.in[4]) + (size_t)l * FF * D;
    const float* const g1 = (ffn ? F.in[14] : F.in[1]) + (size_t)l * D;
    if (r < 3 * I_GU) {
        if (r < 2 * I_GU) { const int isup = r >= I_GU; if (isup) r -= I_GU; const int kb = r / (FF / 64), nb = r % (FF / 64);
            W = isup ? up : gate; gk = g1; Bt = F.W1T + (size_t)(l * 2 + ffn) * (2 * FF) * D; N = FF; K = D; k0 = kb * 64; n0 = nb * 64; nrow0 = ((nb * 64) >> 7) * 256 + ((nb * 64) & 127) + (isup ? 128 : 0); }
        else { r -= 2 * I_GU; const int kb = r / (D / 64), nb = r % (D / 64);
            W = down; gk = nullptr; Bt = F.WDT + (size_t)(l * 2 + ffn) * D * FF; N = D; K = FF; k0 = kb * 64; n0 = nb * 64; nrow0 = nb * 64; }
    } else { r -= 3 * I_GU;
        if (r < I_IN) { const int kb = r / (PROJ / 64), nb = r % (PROJ / 64);
            W = F.in[6] + (size_t)l * D * PROJ; gk = F.in[5] + (size_t)l * D; Bt = F.WINT + (size_t)l * PROJ * D; N = PROJ; K = D; k0 = kb * 64; n0 = nb * 64; nrow0 = nb * 64; }
        else { r -= I_IN; const int kb = r / (D / 64), nb = r % (D / 64);
            W = F.in[13] + (size_t)l * D * D; gk = nullptr; Bt = F.WOUTT + (size_t)l * D * D; N = D; K = D; k0 = kb * 64; n0 = nb * 64; nrow0 = nb * 64; }
    }
}
#define TR_LOAD(v, W, N, k0, n0) do { _Pragma("unroll") for (int i = 0; i < 16; ++i) v[i] = __builtin_nontemporal_load((const GAS f32x4*)((W) + (size_t)((k0) + 4 * i + kq) * (N) + (n0) + 4 * nq)); } while (0)
#define TR_EMIT(v, gk, Bt, K, k0, nrow0) do { float sc[16];                      \
        if (gk) { _Pragma("unroll") for (int i = 0; i < 16; ++i) sc[i] = (gk)[(k0) + 4 * i + kq]; } else { _Pragma("unroll") for (int i = 0; i < 16; ++i) sc[i] = 1.0f; } \
        _Pragma("unroll") for (int i = 0; i < 16; ++i) { const int kk = 4 * i + kq; const float s = sc[i]; \
            T[(4 * nq + 0) * 65 + kk] = v[i][0] * s; T[(4 * nq + 1) * 65 + kk] = v[i][1] * s; T[(4 * nq + 2) * 65 + kk] = v[i][2] * s; T[(4 * nq + 3) * 65 + kk] = v[i][3] * s; } \
        LDS_WAIT(); asm volatile("" ::: "memory"); \
        _Pragma("unroll") for (int j = 0; j < 8; ++j) { const int n = (lane >> 3) + 8 * j; const LAS float* p = T + n * 65 + 8 * c; \
            v4u o; o.x = cvtpk(p[0], p[1]); o.y = cvtpk(p[2], p[3]); o.z = cvtpk(p[4], p[5]); o.w = cvtpk(p[6], p[7]); \
            __builtin_nontemporal_store(o, (GAS v4u*)((Bt) + (size_t)((nrow0) + n) * (K) + (k0) + 8 * c)); } \
        LDS_WAIT(); asm volatile("" ::: "memory"); } while (0)
__device__ __forceinline__ void convert_items(Frame& F, int l, int it0, int it1, int wrank, int nw) {
    LAS float* T = (LAS float*)(F.lds + F.wave * 16640);
    int it = it0 + wrank; if (it >= it1) return;
    const int lane = F.lane, kq = lane >> 4, nq = lane & 15, c = lane & 7;
    f32x4 va[16], vb[16];
    const float *Wa, *ga, *Wb, *gb; bf16 *Ba, *Bb; int Na, Ka, k0a, n0a, nra, Nb, Kb, k0b, n0b, nrb;
    tr_decode(F, l, it, Wa, ga, Ba, Na, Ka, k0a, n0a, nra); TR_LOAD(va, Wa, Na, k0a, n0a);
    bool hb = it + nw < it1;
    if (hb) { tr_decode(F, l, it + nw, Wb, gb, Bb, Nb, Kb, k0b, n0b, nrb); TR_LOAD(vb, Wb, Nb, k0b, n0b); }
    for (;;) {
        TR_EMIT(va, ga, Ba, Ka, k0a, nra);
        if (!hb) break;
        it += 2 * nw; const bool ha = it < it1;
        if (ha) { tr_decode(F, l, it, Wa, ga, Ba, Na, Ka, k0a, n0a, nra); TR_LOAD(va, Wa, Na, k0a, n0a); }
        TR_EMIT(vb, gb, Bb, Kb, k0b, nrb);
        if (!ha) break;
        hb = it + nw < it1;
        if (hb) { tr_decode(F, l, it + nw, Wb, gb, Bb, Nb, Kb, k0b, n0b, nrb); TR_LOAD(vb, Wb, Nb, k0b, n0b); }
    }
}
#undef TR_LOAD
#undef TR_EMIT
constexpr int IT_GU = 2 * I_GU, IT_A_END = 3 * I_GU + I_IN;
__device__ __forceinline__ void p0_prologue(Frame& F) {
    const int gw = F.vcu * NWAVES + F.wave, NGW = F.G * NWAVES;
    if (MK_TAILFILL && F.G == 256) convert_items(F, 0, 0, IT_GU, gw, NGW);
    else for (int l = 0; l < DEPTH; ++l) convert_items(F, l, 0, PER_LAYER, gw, NGW);
    const int gt = F.vcu * (NWAVES * 64) + F.tid, NGT = F.G * NWAVES * 64;
    for (int i = gt; i < DEPTH * 4 * 256 * 32; i += NGT) { const int c8 = i & 31, d = (i >> 5) & 255, lg = i >> 13;
        const float* src = F.in[7] + ((size_t)lg * 256 + 8 * c8) * 256 + d; const float sc = F.in[8][(size_t)lg * 256 + d];
        v4u o; o.x = cvtpk(src[0 * 256] * sc, src[1 * 256] * sc); o.y = cvtpk(src[2 * 256] * sc, src[3 * 256] * sc); o.z = cvtpk(src[4 * 256] * sc, src[5 * 256] * sc); o.w = cvtpk(src[6 * 256] * sc, src[7 * 256] * sc);
        *(GAS v4u*)(F.POOLWT + ((size_t)lg * 256 + d) * 256 + 8 * c8) = o; }
    for (int i = gt; i < DEPTH * 12 * 128 * 16; i += NGT) { const int s8 = i & 15, t = (i >> 4) & 127; const float* src = F.in[11] + (size_t)i * 8; float w[8];
#pragma unroll
        for (int j = 0; j < 8; ++j) w[j] = (8 * s8 + j <= t) ? src[j] : 0.f;
        v4u o; o.x = cvtpk(w[0], w[1]); o.y = cvtpk(w[2], w[3]); o.z = cvtpk(w[4], w[5]); o.w = cvtpk(w[6], w[7]);
        *(GAS v4u*)(F.SGUWB + (size_t)i * 8) = o; }
    for (int m = gw; m < M; m += NGW) { const GAS f32x4* xr = (const GAS f32x4*)(F.in[0] + (size_t)m * D) + F.lane; float ss = 0.f;
        GAS unsigned long long* o8 = (GAS unsigned long long*)(F.XB + (size_t)m * D) + F.lane;
#pragma unroll
        for (int j = 0; j < 16; ++j) { const f32x4 v = xr[64 * j]; ss += (v.x * v.x + v.y * v.y) + (v.z * v.z + v.w * v.w);
            o8[64 * j] = (unsigned long long)cvtpk(v.x, v.y) | ((unsigned long long)cvtpk(v.z, v.w) << 32); }
        ss = wave_sum(ss);
        if (F.lane < 16) F.PART[(size_t)m * 16 + F.lane] = (F.lane == 0) ? ss : 0.f; }
}

template <int W> __device__ __forceinline__ void pool_window(Frame& F, const bf16* prj, int R0, int g, LAS unsigned char* PA) {
    const int c8 = F.tid & 31, seg = F.tid >> 5, t0 = seg * 8;
    const int tl0 = (R0 & (SEQ - 1)) + t0;
    const bf16* src = prj + (size_t)(R0 + t0) * PROJ + C_A + g * 256 + c8 * 8;
    v4u rows[8 + W - 1];
#pragma unroll
    for (int i = 0; i < 8 + W - 1; ++i) { const int dt = i - (W - 1); rows[i] = (tl0 + dt >= 0) ? *(const GAS v4u*)(src + (ptrdiff_t)dt * PROJ) : (v4u){0u, 0u, 0u, 0u}; }
    float S[8];
#pragma unroll
    for (int j = 0; j < 8; ++j) S[j] = 0.f;
#pragma unroll
    for (int i = 0; i < W - 1; ++i) { const v4u r = rows[i]; S[0] += bflo(r.x); S[1] += bfhi(r.x); S[2] += bflo(r.y); S[3] += bfhi(r.y); S[4] += bflo(r.z); S[5] += bfhi(r.z); S[6] += bflo(r.w); S[7] += bfhi(r.w); }
#pragma unroll
    for (int t = 0; t < 8; ++t) { const v4u r = rows[t + W - 1];
        const float a[8] = {bflo(r.x), bfhi(r.x), bflo(r.y), bfhi(r.y), bflo(r.z), bfhi(r.z), bflo(r.w), bfhi(r.w)};
#pragma unroll
        for (int j = 0; j < 8; ++j) S[j] += a[j];
        const int cnt = (tl0 + t + 1 < W) ? (tl0 + t + 1) : W; const float ic = 1.0f / (float)cnt;
        v4u o; o.x = cvtpk(S[0] * ic - a[0], S[1] * ic - a[1]); o.y = cvtpk(S[2] * ic - a[2], S[3] * ic - a[3]); o.z = cvtpk(S[4] * ic - a[4], S[5] * ic - a[5]); o.w = cvtpk(S[6] * ic - a[6], S[7] * ic - a[7]);
        *(LAS v4u*)(PA + (t0 + t) * 528 + c8 * 16) = o;
        const v4u q = rows[t];
        S[0] -= bflo(q.x); S[1] -= bfhi(q.x); S[2] -= bflo(q.y); S[3] -= bfhi(q.y); S[4] -= bflo(q.z); S[5] -= bfhi(q.z); S[6] -= bflo(q.w); S[7] -= bfhi(q.w); }
}
__device__ __forceinline__ void pool_unit(Frame& F, int l, int ck, int g) {
    LAS unsigned char* PA = F.lds;
    LAS unsigned char* WH = F.lds + 67584;
    const int R0 = ck * 128;
    const bf16* Wt = F.POOLWT + (size_t)(l * 4 + g) * 256 * 256;
    const int wrow = F.tid >> 5, wch = F.tid & 31;
    v4u w0[8], w1[8];
#pragma unroll
    for (int j = 0; j < 8; ++j) w0[j] = *(const GAS v4u*)(Wt + (size_t)(wrow + 16 * j) * 256 + wch * 8);
    if (g == 0) pool_window<2>(F, F.PRJ, R0, g, PA); else if (g == 1) pool_window<4>(F, F.PRJ, R0, g, PA); else if (g == 2) pool_window<8>(F, F.PRJ, R0, g, PA); else pool_window<16>(F, F.PRJ, R0, g, PA);
#pragma unroll
    for (int j = 0; j < 8; ++j) *(LAS v4u*)(WH + (wrow + 16 * j) * 528 + wch * 16) = w0[j];
#pragma unroll
    for (int j = 0; j < 8; ++j) w1[j] = *(const GAS v4u*)(Wt + (size_t)(128 + wrow + 16 * j) * 256 + wch * 8);
    __syncthreads();
    const int fr = F.lane & 15, fq = F.lane >> 4, w = F.wave;
    bf16x8 af[8];
#pragma unroll
    for (int kk = 0; kk < 8; ++kk) af[kk] = *(const LAS bf16x8*)(PA + (16 * w + fr) * 528 + kk * 64 + fq * 16);
    bf16* orow = F.MIX + (size_t)(R0 + 16 * w + fr) * D + O_YA + g * 256 + 4 * fq;
#pragma unroll
    for (int half = 0; half < 2; ++half) {
#pragma unroll 2
        for (int n = 0; n < 8; ++n) { f32x4 acc = {0.f, 0.f, 0.f, 0.f}; const LAS unsigned char* wp = WH + (16 * n + fr) * 528 + fq * 16;
#pragma unroll
            for (int kk = 0; kk < 8; ++kk) { const bf16x8 bfrag = *(const LAS bf16x8*)(wp + kk * 64); acc = __builtin_amdgcn_mfma_f32_16x16x32_bf16(bfrag, af[kk], acc, 0, 0, 0); }
            *(GAS unsigned long long*)(orow + 128 * half + 16 * n) = (unsigned long long)cvtpk(acc[0], acc[1]) | ((unsigned long long)cvtpk(acc[2], acc[3]) << 32); }
        __syncthreads();
        if (half == 0) {
#pragma unroll
            for (int j = 0; j < 8; ++j) *(LAS v4u*)(WH + (wrow + 16 * j) * 528 + wch * 16) = w1[j];
            __syncthreads(); }
    }
}
__device__ __forceinline__ void sgu_unit(Frame& F, int l, int ck, int h) {
    LAS unsigned char* VT = F.lds + 69632;
    const int R0 = ck * 128;
    const int fr = F.lane & 15, fq = F.lane >> 4, w = F.wave, t = 16 * w + fr;
    const int s = F.tid >> 2, q = F.tid & 3;
    const bf16* src = F.PRJ + (size_t)(R0 + s) * PROJ + C_V + h * 128 + q * 32;
    v4u vr[4];
#pragma unroll
    for (int i = 0; i < 4; ++i) vr[i] = *(const GAS v4u*)(src + 8 * i);
    const bf16* ws = F.SGUWB + ((size_t)(l * 12 + h) * 128 + t) * 128 + fq * 8;
    bf16x8 af[4];
#pragma unroll
    for (int kk = 0; kk < 4; ++kk) af[kk] = *(const GAS bf16x8*)(ws + kk * 32);
    const bf16* up = F.PRJ + (size_t)(R0 + t) * PROJ + C_U + h * 128 + 4 * fq;
    unsigned long long uu[8];
#pragma unroll
    for (int n = 0; n < 8; ++n) uu[n] = *(const GAS unsigned long long*)(up + 16 * n);
    const float bias = F.in[12][(size_t)(l * 12 + h) * 128 + t];
    { float x[32];
#pragma unroll
        for (int i = 0; i < 4; ++i) { const v4u r = vr[i];
            x[8 * i + 0] = gelu_tanh(bflo(r.x)); x[8 * i + 1] = gelu_tanh(bfhi(r.x)); x[8 * i + 2] = gelu_tanh(bflo(r.y)); x[8 * i + 3] = gelu_tanh(bfhi(r.y));
            x[8 * i + 4] = gelu_tanh(bflo(r.z)); x[8 * i + 5] = gelu_tanh(bfhi(r.z)); x[8 * i + 6] = gelu_tanh(bflo(r.w)); x[8 * i + 7] = gelu_tanh(bfhi(r.w)); }
        float sm = 0.f;
#pragma unroll
        for (int i = 0; i < 32; ++i) sm += x[i];
        sm += __shfl_xor(sm, 1); sm += __shfl_xor(sm, 2);
        const float mu = sm * (1.0f / 128.0f); float sq = 0.f;
#pragma unroll
        for (int i = 0; i < 32; ++i) { x[i] -= mu; sq += x[i] * x[i]; }
        sq += __shfl_xor(sq, 1); sq += __shfl_xor(sq, 2);
        const float rstd = __builtin_amdgcn_rsqf(sq * (1.0f / 128.0f) + LN_EPS);
        const float* lg = F.in[10] + (size_t)l * SGU_W + h * 128 + q * 32;
#pragma unroll
        for (int i = 0; i < 32; ++i) { const float y = x[i] * rstd * lg[i]; *(LAS unsigned short*)(VT + (q * 32 + i) * 272 + s * 2) = (unsigned short)(cvtpk(y, y) & 0xffffu); }
    }
    __syncthreads();
    f32x4 acc[8];
#pragma unroll
    for (int n = 0; n < 8; ++n) acc[n] = (f32x4){0.f, 0.f, 0.f, 0.f};
    const int nk = (16 * w + 15) / 32 + 1;
#pragma unroll
    for (int kk = 0; kk < 4; ++kk) if (kk < nk) {
#pragma unroll
        for (int n = 0; n < 8; ++n) { const bf16x8 bfrag = *(const LAS bf16x8*)(VT + (16 * n + fr) * 272 + kk * 64 + fq * 16); acc[n] = __builtin_amdgcn_mfma_f32_16x16x32_bf16(bfrag, af[kk], acc[n], 0, 0, 0); } }
    bf16* op = F.MIX + (size_t)(R0 + t) * D + O_YC + h * 128 + 4 * fq;
#pragma unroll
    for (int n = 0; n < 8; ++n) { const unsigned u0 = (unsigned)uu[n], u1 = (unsigned)(uu[n] >> 32);
        const float y0 = gelu_tanh(bflo(u0)) * (acc[n][0] + bias), y1 = gelu_tanh(bfhi(u0)) * (acc[n][1] + bias), y2 = gelu_tanh(bflo(u1)) * (acc[n][2] + bias), y3 = gelu_tanh(bfhi(u1)) * (acc[n][3] + bias);
        *(GAS unsigned long long*)(op + 16 * n) = (unsigned long long)cvtpk(y0, y1) | ((unsigned long long)cvtpk(y2, y3) << 32); }
    __syncthreads();
}
__device__ __forceinline__ void mixer_phase(Frame& F, int l) {
    const int b = F.vcu;
    for (int u = b; u < (M / 128) * 4; u += F.G) pool_unit(F, l, u >> 2, u & 3);
    for (int u = b; u < (M / 128) * 12; u += F.G) sgu_unit(F, l, u / 12, u % 12);
    const float* cw = F.in[9] + (size_t)l * 3 * CONV_W;
    const int gt = b * (NWAVES * 64) + F.tid, NGT = F.G * NWAVES * 64;
    for (int item = gt; item < (M / 16) * (CONV_W / 8); item += NGT) { const int seg = item / (CONV_W / 8), c = (item - seg * (CONV_W / 8)) * 8, row0 = seg * 16, tl0 = row0 & (SEQ - 1);
        const bf16* p = F.PRJ + (size_t)row0 * PROJ + c; bf16* o = F.MIX + (size_t)row0 * D + O_YB + c;
        float w0[8], w1[8], w2[8], z1[8], z2[8];
#pragma unroll
        for (int j = 0; j < 8; ++j) { w0[j] = cw[c + j]; w1[j] = cw[CONV_W + c + j]; w2[j] = cw[2 * CONV_W + c + j]; z1[j] = 0.f; z2[j] = 0.f; }
        if (tl0 >= 2) {
            const v4u g1 = *(const GAS v4u*)(p - PROJ + C_GC), x1 = *(const GAS v4u*)(p - PROJ + C_XC), g2 = *(const GAS v4u*)(p - 2 * PROJ + C_GC), x2 = *(const GAS v4u*)(p - 2 * PROJ + C_XC);
            z1[0] = bflo(g1.x) * bflo(x1.x); z1[1] = bfhi(g1.x) * bfhi(x1.x); z1[2] = bflo(g1.y) * bflo(x1.y); z1[3] = bfhi(g1.y) * bfhi(x1.y); z1[4] = bflo(g1.z) * bflo(x1.z); z1[5] = bfhi(g1.z) * bfhi(x1.z); z1[6] = bflo(g1.w) * bflo(x1.w); z1[7] = bfhi(g1.w) * bfhi(x1.w);
            z2[0] = bflo(g2.x) * bflo(x2.x); z2[1] = bfhi(g2.x) * bfhi(x2.x); z2[2] = bflo(g2.y) * bflo(x2.y); z2[3] = bfhi(g2.y) * bfhi(x2.y); z2[4] = bflo(g2.z) * bflo(x2.z); z2[5] = bfhi(g2.z) * bfhi(x2.z); z2[6] = bflo(g2.w) * bflo(x2.w); z2[7] = bfhi(g2.w) * bfhi(x2.w); }
#pragma unroll
        for (int rb = 0; rb < 16; rb += 4) { v4u gb[4], gc[4], xc[4];
#pragma unroll
            for (int r = 0; r < 4; ++r) { const bf16* pr = p + (size_t)(rb + r) * PROJ; gb[r] = *(const GAS v4u*)(pr + C_GB); gc[r] = *(const GAS v4u*)(pr + C_GC); xc[r] = *(const GAS v4u*)(pr + C_XC); }
#pragma unroll
            for (int r = 0; r < 4; ++r) {
                const float gbf[8] = {bflo(gb[r].x), bfhi(gb[r].x), bflo(gb[r].y), bfhi(gb[r].y), bflo(gb[r].z), bfhi(gb[r].z), bflo(gb[r].w), bfhi(gb[r].w)};
                const float z0[8] = {bflo(gc[r].x) * bflo(xc[r].x), bfhi(gc[r].x) * bfhi(xc[r].x), bflo(gc[r].y) * bflo(xc[r].y), bfhi(gc[r].y) * bfhi(xc[r].y), bflo(gc[r].z) * bflo(xc[r].z), bfhi(gc[r].z) * bfhi(xc[r].z), bflo(gc[r].w) * bflo(xc[r].w), bfhi(gc[r].w) * bfhi(xc[r].w)};
                float y[8];
#pragma unroll
                for (int j = 0; j < 8; ++j) { y[j] = gbf[j] * (w0[j] * z2[j] + w1[j] * z1[j] + w2[j] * z0[j]); z2[j] = z1[j]; z1[j] = z0[j]; }
                *(GAS v4u*)(o + (size_t)(rb + r) * D) = (v4u){cvtpk(y[0], y[1]), cvtpk(y[2], y[3]), cvtpk(y[4], y[5]), cvtpk(y[6], y[7])}; } }
    }
}
__device__ __forceinline__ void final_norm(Frame& F) {
    const int gw = F.vcu * NWAVES + F.wave, NGW = F.G * NWAVES;
    for (int m = gw; m < M; m += NGW) { const GAS v4u* xr = (const GAS v4u*)(F.XB + (size_t)m * D) + F.lane; v4u v[8]; float ss = 0.f;
#pragma unroll
        for (int j = 0; j < 8; ++j) { v[j] = xr[64 * j]; const float a0 = bflo(v[j].x), a1 = bfhi(v[j].x), a2 = bflo(v[j].y), a3 = bfhi(v[j].y), a4 = bflo(v[j].z), a5 = bfhi(v[j].z), a6 = bflo(v[j].w), a7 = bfhi(v[j].w);
            ss += ((a0 * a0 + a1 * a1) + (a2 * a2 + a3 * a3)) + ((a4 * a4 + a5 * a5) + (a6 * a6 + a7 * a7)); }
        const float rs = 1.0f / sqrtf(wave_sum(ss) * (1.0f / D) + NORM_EPS);
        GAS f32x4* o = (GAS f32x4*)(F.X + (size_t)m * D); const GAS f32x4* gn = (const GAS f32x4*)F.in[18];
#pragma unroll
        for (int j = 0; j < 8; ++j) { const int q = 2 * (F.lane + 64 * j); const f32x4 g0 = gn[q], g1 = gn[q + 1];
            o[q] = (f32x4){bflo(v[j].x) * rs * g0[0], bfhi(v[j].x) * rs * g0[1], bflo(v[j].y) * rs * g0[2], bfhi(v[j].y) * rs * g0[3]};
            o[q + 1] = (f32x4){bflo(v[j].z) * rs * g1[0], bfhi(v[j].z) * rs * g1[1], bflo(v[j].w) * rs * g1[2], bfhi(v[j].w) * rs * g1[3]}; } }
}
__device__ __forceinline__ void fill_rstd(Frame& F, LAS float* rtab, int pm) {
    if (F.tid < 256) rtab[F.tid] = pg8::row_rstd(F.PART, pm * 256 + F.tid, 1.0f / D, NORM_EPS);
    __syncthreads();
}

struct Args { const float* in[19]; float* out; unsigned char* ws; int ph_lo, ph_hi; };
static_assert(sizeof(Args) == 21 * 8 + 8, "Args has no holes");
__global__ void __launch_bounds__(NWAVES * 64, 2) mk_fwd(Args args) {
    extern __shared__ __attribute__((aligned(16))) unsigned char lds[];
    Frame F;
    F.lds = (LAS unsigned char*)lds;
    F.MISC = (volatile LAS unsigned*)(F.lds + MISC_OFF);
    F.tid = threadIdx.x; F.lane = F.tid & 63; F.wave = __builtin_amdgcn_readfirstlane(F.tid >> 6);
    F.G = gridDim.x; { const int bx = blockIdx.x; F.vcu = (F.G % 8 == 0) ? (bx % 8) * (F.G / 8) + bx / 8 : bx; }
    unsigned char* ws = args.ws;
    F.ctl = (gu32*)(ws + WS_CTL);
#pragma unroll
    for (int i = 0; i < 19; ++i) F.in[i] = args.in[i];
    F.X = args.out;
    F.W1T = (bf16*)(ws + WS_W1); F.WDT = (bf16*)(ws + WS_WD); F.WINT = (bf16*)(ws + WS_WIN); F.WOUTT = (bf16*)(ws + WS_WOUT); F.POOLWT = (bf16*)(ws + WS_POOLW); F.SGUWB = (bf16*)(ws + WS_SGUW);
    F.XB = (bf16*)(ws + WS_XB); F.HID = (bf16*)(ws + WS_HID); F.PRJ = (bf16*)(ws + WS_PROJ); F.MIX = (bf16*)(ws + WS_MIX); F.PART = (float*)(ws + WS_PART);
    if (F.tid < 64) ((LAS unsigned*)(F.lds + MISC_OFF))[F.tid] = 0u;
    __syncthreads();
    XcdBarrier bar = xcd_barrier_post((unsigned*)(F.ctl + CW_BAR), F.MISC + 8);
    const int lo = args.ph_lo, hi = args.ph_hi;
#define IN(k) (lo <= (k) && (k) < hi)
#define SEAM(k) do { if (IN(k) && IN((k) + 1)) xcd_barrier(bar); } while (0)
    LAS float* scr = (LAS float*)(F.lds + SCR_OFF);

    if (IN(0)) p0_prologue(F);
    SEAM(0);
    int ph = 1;
    for (int s = 0; s < 2 * DEPTH; ++s) {
        const int l = s >> 1, second = s & 1;
        const bf16* xb = F.XB; const bf16* hid = F.HID; const bf16* mix = F.MIX; int cblk = (int)blockIdx.x;
        asm volatile("" : "+s"(xb), "+s"(hid), "+s"(mix), "+s"(cblk));
        F.tid = threadIdx.x; asm volatile("" : "+v"(F.tid)); F.lane = F.tid & 63; F.wave = __builtin_amdgcn_readfirstlane(F.tid >> 6);
        asm volatile("" : "+s"(F.vcu));
        if (IN(ph)) { pg8::Gemm g{xb, F.W1T + (size_t)s * (2 * FF) * D, M, 2 * FF, D}; pg8::StaticOrder S; S.init(M, 2 * FF, F.G, cblk);
            pg8::Unit u0; u0.pm = 0; u0.pn = 0; (void)S.next(0, u0); fill_rstd(F, scr, u0.pm);
            pg8::EpiSwiglu E{F.HID, FF, F.PART, 1.0f / D, NORM_EPS, scr, u0.pm};
            pg8::gemm_phase<pg8::EpiSwiglu, pg8::StaticOrder, PG8_ALIGN, PG8_SP2>(F.lds + RING_OFF, g, S, E);
#if MK_TAILFILL
            { constexpr int REM = ((M / 256) * (2 * FF / 256)) % 256;
                if (REM > 0 && F.G == 256 && cblk >= REM) { const int wr_ = (cblk - REM) * NWAVES + F.wave, nw_ = (256 - REM) * NWAVES;
                    if (!second) convert_items(F, l, IT_GU, IT_A_END, wr_, nw_); else if (l + 1 < DEPTH) convert_items(F, l + 1, 0, IT_GU, wr_, nw_); } }
#endif
        }
        SEAM(ph); ++ph;
        if (IN(ph)) { pg8::Gemm g{hid, F.WDT + (size_t)s * D * FF, M, D, FF}; pg8::StaticOrder S; S.init(M, D, F.G, cblk);
            pg8::EpiResid E{F.XB, F.PART, D, 0.5f, scr};
            pg8::gemm_phase<pg8::EpiResid, pg8::StaticOrder, PG8_ALIGN, PG8_SP2>(F.lds + RING_OFF, g, S, E); }
        SEAM(ph); ++ph;
        if (!second) {
            if (IN(ph)) { pg8::Gemm g{xb, F.WINT + (size_t)l * PROJ * D, M, PROJ, D}; pg8::StaticOrder S; S.init(M, PROJ, F.G, cblk);
                pg8::Unit u0; u0.pm = 0; u0.pn = 0; (void)S.next(0, u0); fill_rstd(F, scr, u0.pm);
                pg8::EpiScaleBf16 E{F.PRJ, PROJ, F.PART, 1.0f / D, NORM_EPS, scr, u0.pm};
                pg8::gemm_phase<pg8::EpiScaleBf16, pg8::StaticOrder, PG8_ALIGN, PG8_SP2>(F.lds + RING_OFF, g, S, E);
#if MK_TAILFILL
                { constexpr int REM = ((M / 256) * (PROJ / 256)) % 256;
                    if (REM > 0 && F.G == 256 && cblk >= REM) convert_items(F, l, IT_A_END, PER_LAYER, (cblk - REM) * NWAVES + F.wave, (256 - REM) * NWAVES); }
#endif
            }
            SEAM(ph); ++ph;
            if (IN(ph)) mixer_phase(F, l);
            SEAM(ph); ++ph;
            if (IN(ph)) { pg8::Gemm g{mix, F.WOUTT + (size_t)l * D * D, M, D, D}; pg8::StaticOrder S; S.init(M, D, F.G, cblk);
                pg8::EpiResid E{F.XB, F.PART, D, 1.0f, scr};
                pg8::gemm_phase<pg8::EpiResid, pg8::StaticOrder, PG8_ALIGN, PG8_SP2>(F.lds + RING_OFF, g, S, E); }
            SEAM(ph); ++ph;
        }
    }
    F.tid = threadIdx.x; asm volatile("" : "+v"(F.tid)); F.lane = F.tid & 63; F.wave = __builtin_amdgcn_readfirstlane(F.tid >> 6);
    if (IN(ph)) final_norm(F);
#undef IN
#undef SEAM
}

extern "C" void kernel_launch(void* const* d_in, const int* in_sizes, int n_in, void* d_out, int out_size, void* d_ws, size_t ws_size, hipStream_t stream) {
    static int grid = 0;
    if (grid == 0) {
        if (n_in != 19 || in_sizes[0] != M * D || out_size != M * D || ws_size < WS_END) { fprintf(stderr, "kernel_launch: built for 19 inputs, x and out of %d floats, >= %zu bytes of workspace; got n_in %d, in0 %d, out %d, ws %zu; nothing launched\n", M * D, (size_t)WS_END, n_in, n_in > 0 ? in_sizes[0] : -1, out_size, ws_size); grid = -1; return; }
        int dev = 0, cus = 0, per_cu = 0;
        if (hipGetDevice(&dev) != hipSuccess || hipDeviceGetAttribute(&cus, hipDeviceAttributeMultiprocessorCount, dev) != hipSuccess) { fprintf(stderr, "kernel_launch: hipGetDevice / hipDeviceGetAttribute failed; nothing launched\n"); grid = -1; return; }
        if (hipFuncSetAttribute((const void*)mk_fwd, hipFuncAttributeMaxDynamicSharedMemorySize, LDS_BYTES) != hipSuccess) { fprintf(stderr, "kernel_launch: hipFuncSetAttribute failed\n"); grid = -1; return; }
        if (hipOccupancyMaxActiveBlocksPerMultiprocessor(&per_cu, (const void*)mk_fwd, NWAVES * 64, LDS_BYTES) != hipSuccess || per_cu < 1) fprintf(stderr, "kernel_launch: note: occupancy query reports %d workgroups per CU; launching one per CU anyway\n", per_cu);
        (void)hipGetLastError();
        grid = cus;
    }
    if (grid < 0) return;
    if (hipMemsetAsync((char*)d_ws + WS_CTL, 0, CTL_ZERO_BYTES, stream) != hipSuccess) { fprintf(stderr, "kernel_launch: hipMemsetAsync of the control words failed; nothing launched\n"); return; }
    Args a{};
    for (int i = 0; i < 19; ++i) a.in[i] = (const float*)d_in[i];
    a.out = (float*)d_out; a.ws = (unsigned char*)d_ws;
#if MK_PER_PHASE
    for (int p = 0; p < NPHASES; ++p) { a.ph_lo = p; a.ph_hi = p + 1; hipLaunchKernelGGL(mk_fwd, dim3(grid), dim3(NWAVES * 64), LDS_BYTES, stream, a); }
#else
    a.ph_lo = 0; a.ph_hi = NPHASES;
    hipLaunchKernelGGL(mk_fwd, dim3(grid), dim3(NWAVES * 64), LDS_BYTES, stream, a);
#endif
    const hipError_t le = hipPeekAtLastError();
    if (le != hipSuccess) fprintf(stderr, "kernel_launch: launch failed: %s (grid %d x %d threads, %d B LDS)\n", hipGetErrorName(le), grid, NWAVES * 64, LDS_BYTES);
}
```

```cpp
#include <hip/hip_runtime.h>
#include <cstdio>
#include <cstdint>
#include <cstddef>
namespace pg8 {
#define PG8_LAS __attribute__((address_space(3)))
typedef unsigned short bf16_t;
typedef short bf16x8 __attribute__((ext_vector_type(8)));
typedef float f32x4 __attribute__((ext_vector_type(4)));
typedef unsigned u32x4 __attribute__((ext_vector_type(4)));
constexpr int BM = 256, BK = 64, HALF = 128, HTB = HALF * BK * 2  , STAGE_BYTES = 8 * HTB, NXCD = 8, WGM = 8;

__host__ __device__ __forceinline__ int lds_byte(int r, int c) { const int st = (r >> 4) * 2 + (c >> 5), rr = r & 15, cc = c & 31, ob = rr * 64 + cc * 2; return st * 1024 + (ob ^ (((ob >> 9) & 1) << 5)); }
__host__ __device__ __forceinline__ void stage_rc(int b, int& R, int& C) { const int st = b / 1024, sb = b % 1024, swz = sb ^ (((sb >> 9) & 1) << 5); R = (st >> 1) * 16 + swz / 64; C = (st & 1) * 32 + (swz % 64) / 2; }
__host__ __device__ __forceinline__ int perm32(int rho) { const int n = rho >> 4, i = rho & 15; return 8 * (i >> 2) + 4 * n + (i & 3); }

struct Unit { int pm, pn; };
struct Gemm { const bf16_t* A; const bf16_t* Bt; int M, N, K; };

struct StaticOrder {
    int nM, nN, nwg, G, c;
    __host__ __device__ void init(int M, int N, int G_, int c_) { nM = M / BM; nN = N / BM; nwg = nM * nN; G = G_; c = c_; }
    __host__ __device__ bool next(int i, Unit& u) const {
        const long L = (long)i * G + c; if (L >= nwg) return false;
        int wgid = (int)L; { const int q = nwg / NXCD, r = nwg % NXCD, xcd = wgid % NXCD, off = wgid / NXCD; wgid = (xcd < r ? xcd * (q + 1) : r * (q + 1) + (xcd - r) * q) + off; }
        const int nig = WGM * nN, gid = wgid / nig, fm = gid * WGM, gsz = (nM - fm) < WGM ? (nM - fm) : WGM;
        u.pm = fm + ((wgid % nig) % gsz); u.pn = (wgid % nig) / gsz; return true;
    }
    __device__ __forceinline__ void a_ready(const Unit&) const {}
    __device__ __forceinline__ void done(const Unit&) const {}
};
typedef float f32x2 __attribute__((ext_vector_type(2)));
typedef __bf16 bf16x2_t __attribute__((ext_vector_type(2)));
__device__ __forceinline__ unsigned cvt_pk_bf16(float lo, float hi) { const f32x2 v = {lo, hi}; return __builtin_bit_cast(unsigned, __builtin_convertvector(v, bf16x2_t)); }
typedef unsigned u32x2 __attribute__((ext_vector_type(2)));
constexpr int NPART = 16;
__device__ __forceinline__ float row_rstd(const float* part, int row, float inv_d, float eps) {
    const f32x4* p = (const f32x4*)(part + (size_t)row * NPART);
    const f32x4 a = p[0], b = p[1], c = p[2], d = p[3];
    const f32x4 s = (a + b) + (c + d);
    return __builtin_amdgcn_rsqf(((s[0] + s[1]) + (s[2] + s[3])) * inv_d + eps);
}
__device__ __forceinline__ float swiglu1(float g, float u) { const float e = __builtin_amdgcn_exp2f(-1.44269504089f * g); return g * u * __builtin_amdgcn_rcpf(1.0f + e); }

struct EpiSwiglu {
    static constexpr bool PERM = true, AFTER_DRAIN = false;
    bf16_t* H; int ldh; const float* part; float inv_d, eps; const PG8_LAS float* rtab; int pm0;
    __device__ __forceinline__ void operator()(const f32x4 (&acc)[2][2][4][2], const Unit& u, int wr, int wc, int fr, int fq) const {
        const int row0 = u.pm * BM + wr * 64 + fr, col0 = u.pn * HALF + wc * 32 + 8 * fq;
#pragma unroll
        for (int ai = 0; ai < 2; ++ai)
#pragma unroll
            for (int m = 0; m < 4; ++m) { const int row = row0 + ai * HALF + m * 16; const float rs = (u.pm == pm0) ? rtab[ai * HALF + wr * 64 + m * 16 + fr] : row_rstd(part, row, inv_d, eps);
                const f32x4 g0 = acc[ai][0][m][0] * rs, g1 = acc[ai][0][m][1] * rs, u0 = acc[ai][1][m][0] * rs, u1 = acc[ai][1][m][1] * rs;
                u32x4 w; w.x = cvt_pk_bf16(swiglu1(g0[0], u0[0]), swiglu1(g0[1], u0[1])); w.y = cvt_pk_bf16(swiglu1(g0[2], u0[2]), swiglu1(g0[3], u0[3]));
                w.z = cvt_pk_bf16(swiglu1(g1[0], u1[0]), swiglu1(g1[1], u1[1])); w.w = cvt_pk_bf16(swiglu1(g1[2], u1[2]), swiglu1(g1[3], u1[3]));
                *(u32x4*)(H + (size_t)row * ldh + col0) = w;
                if (m & 1) asm volatile("" ::: "memory"); }
    }
};
struct EpiScaleBf16 {
    static constexpr bool PERM = true, AFTER_DRAIN = false;
    bf16_t* O; int ldo; const float* part; float inv_d, eps; const PG8_LAS float* rtab; int pm0; int zlo, zhi;
    __device__ __forceinline__ void operator()(const f32x4 (&acc)[2][2][4][2], const Unit& u, int wr, int wc, int fr, int fq) const {
        const bool zt = u.pn >= zlo && u.pn < zhi;
        const int cb = u.pn < zlo ? u.pn * BM : zt ? zlo * BM + (u.pn - zlo) * HALF : u.pn * BM - (zhi - zlo) * HALF;
        const int row0 = u.pm * BM + wr * 64 + fr, col0 = cb + wc * 32 + 8 * fq;
#pragma unroll
        for (int ai = 0; ai < 2; ++ai)
#pragma unroll
            for (int m = 0; m < 4; ++m) { const int row = row0 + ai * HALF + m * 16; const float rs = (u.pm == pm0) ? rtab[ai * HALF + wr * 64 + m * 16 + fr] : row_rstd(part, row, inv_d, eps);
                bf16_t* rowp = O + (size_t)row * ldo + col0;
                if (zt) { const float r2 = rs * rs; const f32x4 v0 = acc[ai][0][m][0] * acc[ai][1][m][0] * r2, v1 = acc[ai][0][m][1] * acc[ai][1][m][1] * r2;
                    u32x4 w; w.x = cvt_pk_bf16(v0[0], v0[1]); w.y = cvt_pk_bf16(v0[2], v0[3]); w.z = cvt_pk_bf16(v1[0], v1[1]); w.w = cvt_pk_bf16(v1[2], v1[3]);
                    *(u32x4*)rowp = w; }
                else {
#pragma unroll
                for (int bj = 0; bj < 2; ++bj) { const f32x4 v0 = acc[ai][bj][m][0] * rs, v1 = acc[ai][bj][m][1] * rs;
                    u32x4 w; w.x = cvt_pk_bf16(v0[0], v0[1]); w.y = cvt_pk_bf16(v0[2], v0[3]); w.z = cvt_pk_bf16(v1[0], v1[1]); w.w = cvt_pk_bf16(v1[2], v1[3]);
                    *(u32x4*)(rowp + bj * HALF) = w; } }
                if (m & 1) asm volatile("" ::: "memory"); }
    }
};
__device__ __forceinline__ float bf_lo(unsigned w) { return __builtin_bit_cast(float, w << 16); }
__device__ __forceinline__ float bf_hi(unsigned w) { return __builtin_bit_cast(float, w & 0xffff0000u); }
struct EpiResid {
    static constexpr bool PERM = true, AFTER_DRAIN = false;
    bf16_t* XB; float* part; int ld; float alpha; PG8_LAS float* scr;
    __device__ __forceinline__ void operator()(const f32x4 (&acc)[2][2][4][2], const Unit& u, int wr, int wc, int fr, int fq) const {
        const int row0 = u.pm * BM + wr * 64 + fr, col0 = u.pn * BM + wc * 32 + 8 * fq;
        u32x4 xin[2][4][2];
#pragma unroll
        for (int ai = 0; ai < 2; ++ai)
#pragma unroll
            for (int m = 0; m < 4; ++m)
#pragma unroll
                for (int bj = 0; bj < 2; ++bj) xin[ai][m][bj] = *(const u32x4*)(XB + (size_t)(row0 + ai * HALF + m * 16) * ld + col0 + bj * HALF);
#pragma unroll
        for (int ai = 0; ai < 2; ++ai)
#pragma unroll
            for (int m = 0; m < 4; ++m) { const size_t off = (size_t)(row0 + ai * HALF + m * 16) * ld + col0; float ss = 0.f;
#pragma unroll
                for (int bj = 0; bj < 2; ++bj) { const u32x4 x = xin[ai][m][bj]; const f32x4 a0 = acc[ai][bj][m][0] * alpha, a1 = acc[ai][bj][m][1] * alpha;
                    u32x4 w; w.x = cvt_pk_bf16(bf_lo(x.x) + a0[0], bf_hi(x.x) + a0[1]); w.y = cvt_pk_bf16(bf_lo(x.y) + a0[2], bf_hi(x.y) + a0[3]);
                    w.z = cvt_pk_bf16(bf_lo(x.z) + a1[0], bf_hi(x.z) + a1[1]); w.w = cvt_pk_bf16(bf_lo(x.w) + a1[2], bf_hi(x.w) + a1[3]);
                    *(u32x4*)(XB + off + bj * HALF) = w;
                    const float r0 = bf_lo(w.x), r1 = bf_hi(w.x), r2 = bf_lo(w.y), r3 = bf_hi(w.y), r4 = bf_lo(w.z), r5 = bf_hi(w.z), r6 = bf_lo(w.w), r7 = bf_hi(w.w);
                    ss += ((r0 * r0 + r1 * r1) + (r2 * r2 + r3 * r3)) + ((r4 * r4 + r5 * r5) + (r6 * r6 + r7 * r7)); }
                ss += __shfl_xor(ss, 16); ss += __shfl_xor(ss, 32);
                if (fq == 0) scr[(ai * HALF + wr * 64 + m * 16 + fr) * 4 + wc] = ss; }
        asm volatile("s_waitcnt lgkmcnt(0)" ::: "memory"); __builtin_amdgcn_s_barrier(); asm volatile("" ::: "memory");
        const int lane = fq * 16 + fr;
        if (lane < 32) { const int rl = (wc >> 1) * HALF + wr * 64 + (wc & 1) * 32 + lane;
            const f32x4 v = *(const PG8_LAS f32x4*)(scr + rl * 4);
            part[(size_t)(u.pm * BM + rl) * NPART + u.pn] = (v[0] + v[1]) + (v[2] + v[3]); }
    }
};

template <class Epi, class Sched, bool ALIGN_EPI = false, bool SP2 = false>
__device__ __forceinline__ void gemm_phase(PG8_LAS unsigned char* lds, const Gemm g, const Sched& S, const Epi& E) {
    int tid_ = threadIdx.x; asm volatile("" : "+v"(tid_));
    const int tid = tid_, wid = __builtin_amdgcn_readfirstlane(tid >> 6), lane = tid & 63, wr = wid >> 2, wc = wid & 3, fr = lane & 15, fq = lane >> 4;
    const int K = g.K, nt = K / BK;
    unsigned voffA[2], voffB[2];
#pragma unroll
    for (int i = 0; i < 2; ++i) { int R, C; stage_rc(tid * 16 + i * 8192, R, C); const int Rb = Epi::PERM ? ((R & ~31) + perm32(R & 31)) : R;
        voffA[i] = (unsigned)(R * K + C) * 2u; voffB[i] = (unsigned)(Rb * K + C) * 2u; }
    const size_t kstep = (size_t)(BK * 2);
    const size_t hstep = (size_t)HALF * K * 2;
    const size_t tstep = 2 * hstep;
    const unsigned ldsw = (unsigned)wid * 1024u;
    const int aoff = lds_byte(wr * 64 + fr, fq * 8), boff = lds_byte(wc * 32 + fr, fq * 8);
#define PG8_SA(b, h) (((b) * 2 + (h)) * HTB)
#define PG8_SB(b, h) ((4 + (b) * 2 + (h)) * HTB)
#define PG8_STAGE(bufoff, gbase, voff) do { _Pragma("unroll") for (int _i = 0; _i < 2; ++_i) \
        __builtin_amdgcn_global_load_lds((const unsigned*)((const char*)(gbase) + (voff)[_i]), (PG8_LAS unsigned*)(lds + (bufoff) + ldsw + _i * 8192), 16, 0, 0); } while (0)
#define PG8_LDA(dst, b, h) do { _Pragma("unroll") for (int m = 0; m < 4; ++m) _Pragma("unroll") for (int k = 0; k < 2; ++k) dst[m][k] = *(const PG8_LAS bf16x8*)(lds + PG8_SA(b, h) + aoff + m * 2048 + k * 1024); } while (0)
#define PG8_LDB(dst, b, h) do { _Pragma("unroll") for (int n = 0; n < 2; ++n) _Pragma("unroll") for (int k = 0; k < 2; ++k) dst[n][k] = *(const PG8_LAS bf16x8*)(lds + PG8_SB(b, h) + boff + n * 2048 + k * 1024); } while (0)
#define PG8_MMA(ai, bj, At, Bt) do { __builtin_amdgcn_s_setprio(1); _Pragma("unroll") for (int m = 0; m < 4; ++m) _Pragma("unroll") for (int n = 0; n < 2; ++n) _Pragma("unroll") for (int k = 0; k < 2; ++k) \
        acc[ai][bj][m][n] = __builtin_amdgcn_mfma_f32_16x16x32_bf16(Bt[n][k], At[m][k], acc[ai][bj][m][n], 0, 0, 0); __builtin_amdgcn_s_setprio(0); } while (0)
#define PG8_WAIT_V(n) asm volatile("s_waitcnt vmcnt(" #n ")" ::: "memory")
#define PG8_WAIT_L(n) asm volatile("s_waitcnt lgkmcnt(" #n ")" ::: "memory")
#define PG8_BAR __builtin_amdgcn_s_barrier()
#define PG8_SCHED __builtin_amdgcn_sched_barrier(0)
    Unit cur, nxt; int ui = 0;
    if (!S.next(0, cur)) return;
    f32x4 acc[2][2][4][2];
#pragma unroll
    for (int a = 0; a < 2; ++a)
#pragma unroll
        for (int b = 0; b < 2; ++b)
#pragma unroll
            for (int m = 0; m < 4; ++m)
#pragma unroll
                for (int n = 0; n < 2; ++n) acc[a][b][m][n] = (f32x4){0.f, 0.f, 0.f, 0.f};
    bf16x8 At[4][2], B0[2][2], B1[2][2];
    const char* cA = (const char*)g.A + (size_t)cur.pm * tstep; const char* cB = (const char*)g.Bt + (size_t)cur.pn * tstep;
    S.a_ready(cur);
    if constexpr (SP2) {
        PG8_STAGE(PG8_SB(0, 0), cB, voffB); PG8_STAGE(PG8_SB(0, 1), cB + hstep, voffB); PG8_STAGE(PG8_SA(0, 0), cA, voffA); PG8_STAGE(PG8_SA(0, 1), cA + hstep, voffA);
        if (wr == 1) PG8_BAR;
        PG8_WAIT_V(2); PG8_BAR;
        PG8_STAGE(PG8_SB(1, 0), cB + kstep, voffB); PG8_STAGE(PG8_SA(1, 0), cA + kstep, voffA); PG8_STAGE(PG8_SB(1, 1), cB + hstep + kstep, voffB);
        PG8_WAIT_V(6); PG8_BAR;
    } else {
        PG8_STAGE(PG8_SB(0, 0), cB, voffB); PG8_STAGE(PG8_SA(0, 0), cA, voffA); PG8_STAGE(PG8_SB(0, 1), cB + hstep, voffB); PG8_STAGE(PG8_SA(0, 1), cA + hstep, voffA);
        if (wr == 1) PG8_BAR;
        PG8_WAIT_V(4); PG8_BAR;
        PG8_STAGE(PG8_SB(1, 0), cB + kstep, voffB); PG8_STAGE(PG8_SA(1, 0), cA + kstep, voffA); PG8_STAGE(PG8_SB(1, 1), cB + hstep + kstep, voffB);
        PG8_WAIT_V(6); PG8_BAR;
    }
    for (;;) {
        const bool has_next = S.next(ui + 1, nxt);
        const char* nA = has_next ? (const char*)g.A + (size_t)nxt.pm * tstep : cA; const char* nB = has_next ? (const char*)g.Bt + (size_t)nxt.pn * tstep : cB;
        for (int t = 0; t < nt; t += 2) {
            const bool last = (t == nt - 2);
            const char* a1 = cA + (size_t)(t + 1) * kstep;
            const char* a2 = last ? nA : cA + (size_t)(t + 2) * kstep; const char* b2 = last ? nB : cB + (size_t)(t + 2) * kstep;
            const char* a3 = a2 + kstep; const char* b3 = b2 + kstep;
            if (last && has_next) S.a_ready(nxt);
            if constexpr (SP2) {
            PG8_LDB(B0, 0, 0); PG8_LDB(B1, 0, 1); PG8_SCHED; PG8_LDA(At, 0, 0); PG8_STAGE(PG8_SA(1, 1), a1 + hstep, voffA);
            PG8_WAIT_V(8); PG8_WAIT_L(0); PG8_BAR; PG8_MMA(0, 0, At, B0); PG8_MMA(0, 1, At, B1); PG8_BAR; PG8_SCHED;
            PG8_LDA(At, 0, 1); PG8_STAGE(PG8_SB(0, 0), b2, voffB); PG8_STAGE(PG8_SB(0, 1), b2 + hstep, voffB); PG8_STAGE(PG8_SA(0, 0), a2, voffA);
            PG8_WAIT_V(8); PG8_WAIT_L(0); PG8_BAR; PG8_MMA(1, 0, At, B0); PG8_MMA(1, 1, At, B1); PG8_BAR; PG8_SCHED;
            PG8_LDB(B0, 1, 0); PG8_LDB(B1, 1, 1); PG8_SCHED; PG8_LDA(At, 1, 0); PG8_STAGE(PG8_SA(0, 1), a2 + hstep, voffA);
            PG8_WAIT_V(8); PG8_WAIT_L(0); PG8_BAR; PG8_MMA(0, 0, At, B0); PG8_MMA(0, 1, At, B1); PG8_BAR; PG8_SCHED;
            PG8_LDA(At, 1, 1); PG8_STAGE(PG8_SB(1, 0), b3, voffB); PG8_STAGE(PG8_SB(1, 1), b3 + hstep, voffB); PG8_STAGE(PG8_SA(1, 0), a3, voffA);
            PG8_WAIT_V(8); PG8_WAIT_L(0); PG8_BAR; PG8_MMA(1, 0, At, B0); PG8_MMA(1, 1, At, B1); PG8_BAR; PG8_SCHED;
            } else {
            PG8_LDB(B0, 0, 0); PG8_SCHED; PG8_LDA(At, 0, 0); PG8_STAGE(PG8_SA(1, 1), a1 + hstep, voffA);
            PG8_WAIT_L(8); PG8_BAR; PG8_WAIT_L(0); PG8_MMA(0, 0, At, B0); PG8_BAR; PG8_SCHED;
            PG8_LDB(B1, 0, 1); PG8_STAGE(PG8_SB(0, 0), b2, voffB);
            PG8_BAR; PG8_WAIT_L(0); PG8_MMA(0, 1, At, B1); PG8_BAR;
            PG8_LDA(At, 0, 1); PG8_STAGE(PG8_SA(0, 0), a2, voffA);
            PG8_BAR; PG8_WAIT_L(0); PG8_MMA(1, 0, At, B0); PG8_BAR; PG8_SCHED;
            PG8_STAGE(PG8_SB(0, 1), b2 + hstep, voffB);
            PG8_WAIT_V(6); PG8_BAR; PG8_MMA(1, 1, At, B1); PG8_BAR;
            PG8_LDB(B0, 1, 0); PG8_SCHED; PG8_LDA(At, 1, 0); PG8_STAGE(PG8_SA(0, 1), a2 + hstep, voffA);
            PG8_WAIT_L(8); PG8_BAR; PG8_WAIT_L(0); PG8_MMA(0, 0, At, B0); PG8_BAR; PG8_SCHED;
            PG8_LDB(B1, 1, 1); PG8_STAGE(PG8_SB(1, 0), b3, voffB);
            PG8_BAR; PG8_WAIT_L(0); PG8_MMA(0, 1, At, B1); PG8_BAR;
            PG8_LDA(At, 1, 1); PG8_STAGE(PG8_SA(1, 0), a3, voffA);
            PG8_BAR; PG8_WAIT_L(0); PG8_MMA(1, 0, At, B0); PG8_BAR; PG8_SCHED;
            PG8_STAGE(PG8_SB(1, 1), b3 + hstep, voffB);
            PG8_WAIT_V(6); PG8_BAR; PG8_MMA(1, 1, At, B1); PG8_BAR;
            }
        }
        if constexpr (ALIGN_EPI) { if (wr == 0) PG8_BAR; }
        if constexpr (!Epi::AFTER_DRAIN) { E(acc, cur, wr, wc, fr, fq); S.done(cur); }
        if (!has_next) break;
#pragma unroll
        for (int a = 0; a < 2; ++a)
#pragma unroll
            for (int b = 0; b < 2; ++b)
#pragma unroll
                for (int m = 0; m < 4; ++m)
#pragma unroll
                    for (int n = 0; n < 2; ++n) acc[a][b][m][n] = (f32x4){0.f, 0.f, 0.f, 0.f};
        cur = nxt; cA = nA; cB = nB; ++ui;
        if constexpr (ALIGN_EPI) { if (wr == 1) PG8_BAR; }
    }
    PG8_WAIT_V(0);
    if constexpr (!ALIGN_EPI) { if (wr == 0) PG8_BAR; }
    PG8_BAR;
    if constexpr (Epi::AFTER_DRAIN) { E.fused(acc, cur, wr, wc, fr, fq, lds, wid, lane); S.done(cur); }
#undef PG8_SA
#undef PG8_SB
#undef PG8_STAGE
#undef PG8_LDA
#undef PG8_LDB
#undef PG8_MMA
#undef PG8_WAIT_V
#undef PG8_WAIT_L
#undef PG8_BAR
#undef PG8_SCHED
}
}
#ifndef PG8_SP2
#define PG8_SP2 true
#endif
#ifndef PG8_ALIGN
#define PG8_ALIGN true
#endif
constexpr int NWAVES = 8;
#ifndef MK_TAILFILL
#define MK_TAILFILL 1
#endif
#ifndef MK_PER_PHASE
#define MK_PER_PHASE 0
#endif

constexpr int BATCH = 4, SEQ = 2048, D = 4096, DEPTH = 4, FF = 5632;
constexpr int M = BATCH * SEQ;
constexpr int POOL_W = 1024, CONV_W = 1536, SGU_W = 1536, PROJ = 8704;
constexpr int C_A = 0, C_GB = 1024, C_GC = 2560, C_XC = 4096, C_U = 5632, C_V = 7168;
constexpr int PRJ_LD = PROJ - CONV_W, P_A = 0, P_GB = 1024, P_Z = 2560, P_U = 4096, P_V = 5632, Z_LO = C_GC / 256, Z_HI = Z_LO + CONV_W / 128;
static_assert(C_GC % 256 == 0 && CONV_W % 128 == 0 && C_XC == C_GC + CONV_W && C_U == C_XC + CONV_W && Z_HI * 256 == C_U, "z tiles");
constexpr int O_YA = 0, O_YB = 1024, O_YC = 2560;
constexpr float NORM_EPS = 1e-6f, LN_EPS = 1e-5f;
constexpr int NPHASES = 2 + 7 * DEPTH;

constexpr size_t MiB = 1u << 20;
constexpr size_t WS_CTL = 0, CTL_ZERO_BYTES = 1 * MiB;
constexpr size_t SZ_W1 = (size_t)2 * FF * D * 2;
constexpr size_t SZ_WD = (size_t)D * FF * 2;
constexpr size_t SZ_WIN = (size_t)PROJ * D * 2, SZ_WOUT = (size_t)D * D * 2;
constexpr size_t WS_W1 = 2 * MiB;
constexpr size_t WS_WD = WS_W1 + 2 * DEPTH * SZ_W1;
constexpr size_t WS_WIN = WS_WD + 2 * DEPTH * SZ_WD;
constexpr size_t WS_WOUT = WS_WIN + DEPTH * SZ_WIN;
constexpr size_t WS_POOLW = WS_WOUT + DEPTH * SZ_WOUT;
constexpr size_t WS_SGUW = WS_POOLW + (size_t)DEPTH * 4 * 256 * 256 * 2;
constexpr size_t WS_XB = WS_SGUW + (size_t)DEPTH * 12 * 128 * 128 * 2;
constexpr size_t WS_HID = WS_XB + (size_t)M * D * 2;
constexpr size_t WS_PROJ = WS_HID + (size_t)M * FF * 2;
constexpr size_t WS_MIX = WS_PROJ + (size_t)M * PROJ * 2;
constexpr size_t WS_PART = WS_MIX + (size_t)M * D * 2;
constexpr size_t WS_END = WS_PART + (size_t)M * 16 * 4;
static_assert(WS_W1 % 256 == 0 && WS_WD % 256 == 0 && WS_WIN % 256 == 0 && WS_WOUT % 256 == 0 && WS_POOLW % 256 == 0 && WS_SGUW % 256 == 0 && WS_XB % 256 == 0 && WS_HID % 256 == 0 && WS_PROJ % 256 == 0 && WS_MIX % 256 == 0 && WS_PART % 256 == 0, "d_ws map alignment");
constexpr int CW_BAR = 4096;

constexpr int RING_OFF = 0, RING_BYTES = 131072;
constexpr int SCR_OFF = RING_BYTES;
constexpr int LDS_BYTES = 147456;
constexpr int MISC_OFF = LDS_BYTES - 256;
static_assert(SCR_OFF + 4096 <= MISC_OFF, "LDS map");

#define GAS __attribute__((address_space(1)))
#define LAS __attribute__((address_space(3)))
typedef unsigned short bf16;
typedef unsigned v4u __attribute__((ext_vector_type(4)));
typedef float f32x4 __attribute__((ext_vector_type(4)));
typedef short bf16x8 __attribute__((ext_vector_type(8)));
typedef GAS unsigned gu32;
typedef GAS unsigned long long gu64;
#define RLX_AGENT __ATOMIC_RELAXED, __HIP_MEMORY_SCOPE_AGENT
#define LDS_WAIT() asm volatile("s_waitcnt lgkmcnt(0)" ::: "memory")
#define VM_WAIT() asm volatile("s_waitcnt vmcnt(0)" ::: "memory")
__device__ __forceinline__ unsigned long long rt() { return __builtin_amdgcn_s_memrealtime(); }
__device__ __forceinline__ unsigned f2bf(float f) { unsigned u = __builtin_bit_cast(unsigned, f); return (u + 0x7fffu + ((u >> 16) & 1u)) >> 16; }
__device__ __forceinline__ unsigned pk2(float lo, float hi) { return f2bf(lo) | (f2bf(hi) << 16); }
#define XB_TMO      128
#define XB_XCNT(j)  (256  + 64 * (j))
#define XB_XSUB(j)  (1280 + 64 * (j))
#define XB_XGEN(j)  (2304 + 64 * (j))
#define XB_TOP      3328
#define XB_TOPGEN   3392
#define XCD_BAR_WORDS 3456
#define XB_SPIN_CAP (1u << 18)

__device__ __forceinline__ unsigned xb_ld(unsigned* p)              { return __hip_atomic_load(p, __ATOMIC_RELAXED, __HIP_MEMORY_SCOPE_AGENT); }
__device__ __forceinline__ unsigned xb_add(unsigned* p, unsigned v) { return __hip_atomic_fetch_add(p, v, __ATOMIC_RELAXED, __HIP_MEMORY_SCOPE_AGENT); }
__device__ __forceinline__ unsigned xb_xcc_id() { return (unsigned)__builtin_amdgcn_s_getreg((3 << 11) | 20) & 0xFu; }
#define XB_SPIN(cond, bar) do { unsigned _sp = 0; while (cond) { __builtin_amdgcn_s_sleep(1); \
    if ((++_sp & 255u) == 0u) { if (xb_ld(&(bar)[XB_TMO])) break; if (_sp > XB_SPIN_CAP) { atomicAdd(&(bar)[XB_TMO], 1u); break; } } } } while (0)

struct XcdBarrier {
    unsigned* bar; unsigned x;
    volatile LAS unsigned* st;
};

__device__ __forceinline__ XcdBarrier xcd_barrier_post(unsigned* bar, volatile LAS unsigned* st) {
    XcdBarrier b; b.bar = bar; b.x = xb_xcc_id(); b.st = st;
    if (threadIdx.x == 0) (void)xb_add(&bar[XB_XCNT(b.x)], 1u);
    return b;
}
__device__ __forceinline__ void xcd_barrier_complete(unsigned* bar, unsigned x, unsigned& nloc, unsigned& nx) {
    const unsigned G = gridDim.x * gridDim.y * gridDim.z;
    unsigned sum, cnt, mine, sp = 0u;
    for (;;) {
        sum = 0u; cnt = 0u; mine = 0u;
#pragma unroll
        for (unsigned j = 0; j < 16; ++j) { const unsigned c = xb_ld(&bar[XB_XCNT(j)]); sum += c; cnt += (c > 0u) ? 1u : 0u; mine = (j == x) ? c : mine; }
        if (sum == G) break;
        __builtin_amdgcn_s_sleep(1);
        if ((++sp & 255u) == 0u) { if (xb_ld(&bar[XB_TMO])) break; if (sp > XB_SPIN_CAP) { atomicAdd(&bar[XB_TMO], 1u); break; } }
    }
    nloc = mine > 0u ? mine : 1u; nx = cnt > 0u ? cnt : 1u;
}

__device__ __forceinline__ void xcd_barrier(const XcdBarrier& b) {
    asm volatile("s_waitcnt vmcnt(0)" ::: "memory");
    __syncthreads();
    if (threadIdx.x == 0) {
        unsigned* bar = b.bar;
        __builtin_amdgcn_s_waitcnt(0);
        unsigned nloc = b.st[0], nx = b.st[1];
        if (nloc == 0u) { xcd_barrier_complete(bar, b.x, nloc, nx); b.st[0] = nloc; b.st[1] = nx; }
        const unsigned old = xb_add(&bar[XB_XSUB(b.x)], 1u);
        const unsigned gen = old / nloc;
        if (old + 1u == (gen + 1u) * nloc) {
            __builtin_amdgcn_fence(__ATOMIC_RELEASE, "agent");
            asm volatile("s_waitcnt vmcnt(0)" ::: "memory");
            const unsigned og = xb_add(&bar[XB_TOP], 1u);
            const unsigned tg = og / nx;
            if (og + 1u == (tg + 1u) * nx) xb_add(&bar[XB_TOPGEN], 1u);
            else XB_SPIN(xb_ld(&bar[XB_TOPGEN]) == tg, bar);
            __builtin_amdgcn_fence(__ATOMIC_ACQUIRE, "agent");
            xb_add(&bar[XB_XGEN(b.x)], 1u);
            asm volatile("s_waitcnt vmcnt(0)" ::: "memory");
        } else {
            XB_SPIN(xb_ld(&bar[XB_XGEN(b.x)]) == gen, bar);
            __builtin_amdgcn_fence(__ATOMIC_ACQUIRE, "agent");
            asm volatile("s_waitcnt vmcnt(0)" ::: "memory");
        }
    }
    __syncthreads();
}
struct Frame {
    LAS unsigned char* lds;
    volatile LAS unsigned* MISC;
    gu32* ctl;
    int tid, lane, wave;
    int vcu, G;
    const float* in[19];
    float* X;
    bf16 *W1T, *WDT, *WINT, *WOUTT, *POOLWT, *SGUWB;
    bf16 *XB, *HID, *PRJ, *MIX; float* PART;
};
__device__ __forceinline__ float wave_sum(float v) {
#pragma unroll
    for (int o = 1; o < 64; o <<= 1) v += __shfl_xor(v, o);
    return v;
}
__device__ __forceinline__ unsigned cvtpk(float lo, float hi) { return pg8::cvt_pk_bf16(lo, hi); }
__device__ __forceinline__ float bflo(unsigned w) { return __builtin_bit_cast(float, w << 16); }
__device__ __forceinline__ float bfhi(unsigned w) { return __builtin_bit_cast(float, w & 0xffff0000u); }
__device__ __forceinline__ float gelu_tanh(float x) {
    const float y = 0.7978845608028654f * (x + 0.044715f * x * x * x);
    const float e = __builtin_amdgcn_exp2f(-2.8853900817779268f * y);
    return x * __builtin_amdgcn_rcpf(1.0f + e);
}

constexpr int I_GU = (D / 64) * (FF / 64), I_DN = (FF / 64) * (D / 64), I_IN = (D / 64) * (PROJ / 64), I_OUT = (D / 64) * (D / 64);
constexpr int PER_LAYER = 6 * I_GU + I_IN + I_OUT;
static_assert(I_GU == I_DN, "item counts");
__device__ __forceinline__ void tr_decode(Frame& F, int l, int it, const float*& W, const float*& gk, bf16*& Bt, int& N, int& K, int& k0, int& n0, int& nrow0) {
    int r = it;
    const int ffn = (r >= 3 * I_GU + I_IN + I_OUT) ? 1 : 0;
    if (ffn) r -= 3 * I_GU + I_IN + I_OUT;
    const float* const gate = (ffn ? F.in[15] : F.in[2]) + (size_t)l * D * FF; const float* const up = (ffn ? F.in[16] : F.in[3]) + (size_t)l * D * FF; const float* const down = (ffn ? F.in[17] : F.in[4]) + (size_t)l * FF * D;
    const float* const g1 = (ffn ? F.in[14] : F.in[1]) + (size_t)l * D;
    if (r < 3 * I_GU) {
        if (r < 2 * I_GU) { const int isup = r >= I_GU; if (isup) r -= I_GU; const int kb = r / (FF / 64), nb = r % (FF / 64);
            W = isup ? up : gate; gk = g1; Bt = F.W1T + (size_t)(l * 2 + ffn) * (2 * FF) * D; N = FF; K = D; k0 = kb * 64; n0 = nb * 64; nrow0 = ((nb * 64) >> 7) * 256 + ((nb * 64) & 127) + (isup ? 128 : 0); }
        else { r -= 2 * I_GU; const int kb = r / (D / 64), nb = r % (D / 64);
            W = down; gk = nullptr; Bt = F.WDT + (size_t)(l * 2 + ffn) * D * FF; N = D; K = FF; k0 = kb * 64; n0 = nb * 64; nrow0 = nb * 64; }
    } else { r -= 3 * I_GU;
        if (r < I_IN) { const int kb = r / (PROJ / 64), nb = r % (PROJ / 64);
            W = F.in[6] + (size_t)l * D * PROJ; gk = F.in[5] + (size_t)l * D; Bt = F.WINT + (size_t)l * PROJ * D; N = PROJ; K = D; k0 = kb * 64; n0 = nb * 64;
            { const int jg = n0 - C_GC, jx = n0 - C_XC;
                nrow0 = (n0 < C_GC || n0 >= C_U) ? n0 : (n0 < C_XC) ? C_GC + (jg >> 7) * 256 + (jg & 127) : C_GC + (jx >> 7) * 256 + 128 + (jx & 127); } }
        else { r -= I_IN; const int kb = r / (D / 64), nb = r % (D / 64);
            W = F.in[13] + (size_t)l * D * D; gk = nullptr; Bt = F.WOUTT + (size_t)l * D * D; N = D; K = D; k0 = kb * 64; n0 = nb * 64; nrow0 = nb * 64; }
    }
}
#define TR_LOAD(v, W, N, k0, n0) do { _Pragma("unroll") for (int i = 0; i < 16; ++i) v[i] = __builtin_nontemporal_load((const GAS f32x4*)((W) + (size_t)((k0) + 4 * i + kq) * (N) + (n0) + 4 * nq)); } while (0)
#define TR_EMIT(v, gk, Bt, K, k0, nrow0) do { float sc[16];                      \
        if (gk) { _Pragma("unroll") for (int i = 0; i < 16; ++i) sc[i] = (gk)[(k0) + 4 * i + kq]; } else { _Pragma("unroll") for (int i = 0; i < 16; ++i) sc[i] = 1.0f; } \
        _Pragma("unroll") for (int i = 0; i < 16; ++i) { const int kk = 4 * i + kq; const float s = sc[i]; \
            T[(4 * nq + 0) * 65 + kk] = v[i][0] * s; T[(4 * nq + 1) * 65 + kk] = v[i][1] * s; T[(4 * nq + 2) * 65 + kk] = v[i][2] * s; T[(4 * nq + 3) * 65 + kk] = v[i][3] * s; } \
        LDS_WAIT(); asm volatile("" ::: "memory"); \
        _Pragma("unroll") for (int j = 0; j < 8; ++j) { const int n = (lane >> 3) + 8 * j; const LAS float* p = T + n * 65 + 8 * c; \
            v4u o; o.x = cvtpk(p[0], p[1]); o.y = cvtpk(p[2], p[3]); o.z = cvtpk(p[4], p[5]); o.w = cvtpk(p[6], p[7]); \
            __builtin_nontemporal_store(o, (GAS v4u*)((Bt) + (size_t)((nrow0) + n) * (K) + (k0) + 8 * c)); } \
        LDS_WAIT(); asm volatile("" ::: "memory"); } while (0)
__device__ __forceinline__ void convert_items(Frame& F, int l, int it0, int it1, int wrank, int nw) {
    LAS float* T = (LAS float*)(F.lds + F.wave * 16640);
    int it = it0 + wrank; if (it >= it1) return;
    const int lane = F.lane, kq = lane >> 4, nq = lane & 15, c = lane & 7;
    f32x4 va[16], vb[16];
    const float *Wa, *ga, *Wb, *gb; bf16 *Ba, *Bb; int Na, Ka, k0a, n0a, nra, Nb, Kb, k0b, n0b, nrb;
    tr_decode(F, l, it, Wa, ga, Ba, Na, Ka, k0a, n0a, nra); TR_LOAD(va, Wa, Na, k0a, n0a);
    bool hb = it + nw < it1;
    if (hb) { tr_decode(F, l, it + nw, Wb, gb, Bb, Nb, Kb, k0b, n0b, nrb); TR_LOAD(vb, Wb, Nb, k0b, n0b); }
    for (;;) {
        TR_EMIT(va, ga, Ba, Ka, k0a, nra);
        if (!hb) break;
        it += 2 * nw; const bool ha = it < it1;
        if (ha) { tr_decode(F, l, it, Wa, ga, Ba, Na, Ka, k0a, n0a, nra); TR_LOAD(va, Wa, Na, k0a, n0a); }
        TR_EMIT(vb, gb, Bb, Kb, k0b, nrb);
        if (!ha) break;
        hb = it + nw < it1;
        if (hb) { tr_decode(F, l, it + nw, Wb, gb, Bb, Nb, Kb, k0b, n0b, nrb); TR_LOAD(vb, Wb, Nb, k0b, n0b); }
    }
}
#undef TR_LOAD
#undef TR_EMIT
constexpr int IT_GU = 2 * I_GU, IT_A_END = 3 * I_GU + I_IN;
__device__ __forceinline__ void p0_prologue(Frame& F) {
    const int gw = F.vcu * NWAVES + F.wave, NGW = F.G * NWAVES;
    if (MK_TAILFILL && F.G == 256) convert_items(F, 0, 0, IT_GU, gw, NGW);
    else for (int l = 0; l < DEPTH; ++l) convert_items(F, l, 0, PER_LAYER, gw, NGW);
    const int gt = F.vcu * (NWAVES * 64) + F.tid, NGT = F.G * NWAVES * 64;
    for (int i = gt; i < DEPTH * 4 * 256 * 32; i += NGT) { const int c8 = i & 31, d = (i >> 5) & 255, lg = i >> 13;
        const float* src = F.in[7] + ((size_t)lg * 256 + 8 * c8) * 256 + d; const float sc = F.in[8][(size_t)lg * 256 + d];
        v4u o; o.x = cvtpk(src[0 * 256] * sc, src[1 * 256] * sc); o.y = cvtpk(src[2 * 256] * sc, src[3 * 256] * sc); o.z = cvtpk(src[4 * 256] * sc, src[5 * 256] * sc); o.w = cvtpk(src[6 * 256] * sc, src[7 * 256] * sc);
        *(GAS v4u*)(F.POOLWT + ((size_t)lg * 256 + d) * 256 + 8 * c8) = o; }
    for (int i = gt; i < DEPTH * 12 * 128 * 16; i += NGT) { const int s8 = i & 15, t = (i >> 4) & 127; const float* src = F.in[11] + (size_t)i * 8; float w[8];
#pragma unroll
        for (int j = 0; j < 8; ++j) w[j] = (8 * s8 + j <= t) ? src[j] : 0.f;
        v4u o; o.x = cvtpk(w[0], w[1]); o.y = cvtpk(w[2], w[3]); o.z = cvtpk(w[4], w[5]); o.w = cvtpk(w[6], w[7]);
        *(GAS v4u*)(F.SGUWB + (size_t)i * 8) = o; }
    for (int m = gw; m < M; m += NGW) { const GAS f32x4* xr = (const GAS f32x4*)(F.in[0] + (size_t)m * D) + F.lane; float ss = 0.f;
        GAS unsigned long long* o8 = (GAS unsigned long long*)(F.XB + (size_t)m * D) + F.lane;
#pragma unroll
        for (int j = 0; j < 16; ++j) { const f32x4 v = xr[64 * j]; ss += (v.x * v.x + v.y * v.y) + (v.z * v.z + v.w * v.w);
            o8[64 * j] = (unsigned long long)cvtpk(v.x, v.y) | ((unsigned long long)cvtpk(v.z, v.w) << 32); }
        ss = wave_sum(ss);
        if (F.lane < 16) F.PART[(size_t)m * 16 + F.lane] = (F.lane == 0) ? ss : 0.f; }
}

template <int W> __device__ __forceinline__ void pool_window(Frame& F, const bf16* prj, int R0, int g, LAS unsigned char* PA) {
    const int c8 = F.tid & 31, seg = F.tid >> 5, t0 = seg * 8;
    const int tl0 = (R0 & (SEQ - 1)) + t0;
    const bf16* src = prj + (size_t)(R0 + t0) * PRJ_LD + P_A + g * 256 + c8 * 8;
    v4u rows[8 + W - 1];
#pragma unroll
    for (int i = 0; i < 8 + W - 1; ++i) { const int dt = i - (W - 1); rows[i] = (tl0 + dt >= 0) ? *(const GAS v4u*)(src + (ptrdiff_t)dt * PRJ_LD) : (v4u){0u, 0u, 0u, 0u}; }
    float S[8];
#pragma unroll
    for (int j = 0; j < 8; ++j) S[j] = 0.f;
#pragma unroll
    for (int i = 0; i < W - 1; ++i) { const v4u r = rows[i]; S[0] += bflo(r.x); S[1] += bfhi(r.x); S[2] += bflo(r.y); S[3] += bfhi(r.y); S[4] += bflo(r.z); S[5] += bfhi(r.z); S[6] += bflo(r.w); S[7] += bfhi(r.w); }
#pragma unroll
    for (int t = 0; t < 8; ++t) { const v4u r = rows[t + W - 1];
        const float a[8] = {bflo(r.x), bfhi(r.x), bflo(r.y), bfhi(r.y), bflo(r.z), bfhi(r.z), bflo(r.w), bfhi(r.w)};
#pragma unroll
        for (int j = 0; j < 8; ++j) S[j] += a[j];
        const int cnt = (tl0 + t + 1 < W) ? (tl0 + t + 1) : W; const float ic = 1.0f / (float)cnt;
        v4u o; o.x = cvtpk(S[0] * ic - a[0], S[1] * ic - a[1]); o.y = cvtpk(S[2] * ic - a[2], S[3] * ic - a[3]); o.z = cvtpk(S[4] * ic - a[4], S[5] * ic - a[5]); o.w = cvtpk(S[6] * ic - a[6], S[7] * ic - a[7]);
        *(LAS v4u*)(PA + (t0 + t) * 528 + c8 * 16) = o;
        const v4u q = rows[t];
        S[0] -= bflo(q.x); S[1] -= bfhi(q.x); S[2] -= bflo(q.y); S[3] -= bfhi(q.y); S[4] -= bflo(q.z); S[5] -= bfhi(q.z); S[6] -= bflo(q.w); S[7] -= bfhi(q.w); }
}
__device__ __forceinline__ void pool_unit(Frame& F, int l, int ck, int g) {
    LAS unsigned char* PA = F.lds;
    LAS unsigned char* WH = F.lds + 67584;
    const int R0 = ck * 128;
    const bf16* Wt = F.POOLWT + (size_t)(l * 4 + g) * 256 * 256;
    const int wrow = F.tid >> 5, wch = F.tid & 31;
    v4u w0[8], w1[8];
#pragma unroll
    for (int j = 0; j < 8; ++j) w0[j] = *(const GAS v4u*)(Wt + (size_t)(wrow + 16 * j) * 256 + wch * 8);
    if (g == 0) pool_window<2>(F, F.PRJ, R0, g, PA); else if (g == 1) pool_window<4>(F, F.PRJ, R0, g, PA); else if (g == 2) pool_window<8>(F, F.PRJ, R0, g, PA); else pool_window<16>(F, F.PRJ, R0, g, PA);
#pragma unroll
    for (int j = 0; j < 8; ++j) *(LAS v4u*)(WH + (wrow + 16 * j) * 528 + wch * 16) = w0[j];
#pragma unroll
    for (int j = 0; j < 8; ++j) w1[j] = *(const GAS v4u*)(Wt + (size_t)(128 + wrow + 16 * j) * 256 + wch * 8);
    __syncthreads();
    const int fr = F.lane & 15, fq = F.lane >> 4, w = F.wave;
    bf16x8 af[8];
#pragma unroll
    for (int kk = 0; kk < 8; ++kk) af[kk] = *(const LAS bf16x8*)(PA + (16 * w + fr) * 528 + kk * 64 + fq * 16);
    bf16* orow = F.MIX + (size_t)(R0 + 16 * w + fr) * D + O_YA + g * 256 + 4 * fq;
#pragma unroll
    for (int half = 0; half < 2; ++half) {
#pragma unroll 2
        for (int n = 0; n < 8; ++n) { f32x4 acc = {0.f, 0.f, 0.f, 0.f}; const LAS unsigned char* wp = WH + (16 * n + fr) * 528 + fq * 16;
#pragma unroll
            for (int kk = 0; kk < 8; ++kk) { const bf16x8 bfrag = *(const LAS bf16x8*)(wp + kk * 64); acc = __builtin_amdgcn_mfma_f32_16x16x32_bf16(bfrag, af[kk], acc, 0, 0, 0); }
            *(GAS unsigned long long*)(orow + 128 * half + 16 * n) = (unsigned long long)cvtpk(acc[0], acc[1]) | ((unsigned long long)cvtpk(acc[2], acc[3]) << 32); }
        __syncthreads();
        if (half == 0) {
#pragma unroll
            for (int j = 0; j < 8; ++j) *(LAS v4u*)(WH + (wrow + 16 * j) * 528 + wch * 16) = w1[j];
            __syncthreads(); }
    }
}
__device__ __forceinline__ void sgu_unit(Frame& F, int l, int ck, int h) {
    LAS unsigned char* VT = F.lds + 69632;
    const int R0 = ck * 128;
    const int fr = F.lane & 15, fq = F.lane >> 4, w = F.wave, t = 16 * w + fr;
    const int s = F.tid >> 2, q = F.tid & 3;
    const bf16* src = F.PRJ + (size_t)(R0 + s) * PRJ_LD + P_V + h * 128 + q * 32;
    v4u vr[4];
#pragma unroll
    for (int i = 0; i < 4; ++i) vr[i] = *(const GAS v4u*)(src + 8 * i);
    const bf16* ws = F.SGUWB + ((size_t)(l * 12 + h) * 128 + t) * 128 + fq * 8;
    bf16x8 af[4];
#pragma unroll
    for (int kk = 0; kk < 4; ++kk) af[kk] = *(const GAS bf16x8*)(ws + kk * 32);
    const bf16* up = F.PRJ + (size_t)(R0 + t) * PRJ_LD + P_U + h * 128 + 4 * fq;
    unsigned long long uu[8];
#pragma unroll
    for (int n = 0; n < 8; ++n) uu[n] = *(const GAS unsigned long long*)(up + 16 * n);
    const float bias = F.in[12][(size_t)(l * 12 + h) * 128 + t];
    { float x[32];
#pragma unroll
        for (int i = 0; i < 4; ++i) { const v4u r = vr[i];
            x[8 * i + 0] = gelu_tanh(bflo(r.x)); x[8 * i + 1] = gelu_tanh(bfhi(r.x)); x[8 * i + 2] = gelu_tanh(bflo(r.y)); x[8 * i + 3] = gelu_tanh(bfhi(r.y));
            x[8 * i + 4] = gelu_tanh(bflo(r.z)); x[8 * i + 5] = gelu_tanh(bfhi(r.z)); x[8 * i + 6] = gelu_tanh(bflo(r.w)); x[8 * i + 7] = gelu_tanh(bfhi(r.w)); }
        float sm = 0.f;
#pragma unroll
        for (int i = 0; i < 32; ++i) sm += x[i];
        sm += __shfl_xor(sm, 1); sm += __shfl_xor(sm, 2);
        const float mu = sm * (1.0f / 128.0f); float sq = 0.f;
#pragma unroll
        for (int i = 0; i < 32; ++i) { x[i] -= mu; sq += x[i] * x[i]; }
        sq += __shfl_xor(sq, 1); sq += __shfl_xor(sq, 2);
        const float rstd = __builtin_amdgcn_rsqf(sq * (1.0f / 128.0f) + LN_EPS);
        const float* lg = F.in[10] + (size_t)l * SGU_W + h * 128 + q * 32;
#pragma unroll
        for (int i = 0; i < 32; ++i) { const float y = x[i] * rstd * lg[i]; *(LAS unsigned short*)(VT + (q * 32 + i) * 272 + s * 2) = (unsigned short)(cvtpk(y, y) & 0xffffu); }
    }
    __syncthreads();
    f32x4 acc[8];
#pragma unroll
    for (int n = 0; n < 8; ++n) acc[n] = (f32x4){0.f, 0.f, 0.f, 0.f};
    const int nk = (16 * w + 15) / 32 + 1;
#pragma unroll
    for (int kk = 0; kk < 4; ++kk) if (kk < nk) {
#pragma unroll
        for (int n = 0; n < 8; ++n) { const bf16x8 bfrag = *(const LAS bf16x8*)(VT + (16 * n + fr) * 272 + kk * 64 + fq * 16); acc[n] = __builtin_amdgcn_mfma_f32_16x16x32_bf16(bfrag, af[kk], acc[n], 0, 0, 0); } }
    bf16* op = F.MIX + (size_t)(R0 + t) * D + O_YC + h * 128 + 4 * fq;
#pragma unroll
    for (int n = 0; n < 8; ++n) { const unsigned u0 = (unsigned)uu[n], u1 = (unsigned)(uu[n] >> 32);
        const float y0 = gelu_tanh(bflo(u0)) * (acc[n][0] + bias), y1 = gelu_tanh(bfhi(u0)) * (acc[n][1] + bias), y2 = gelu_tanh(bflo(u1)) * (acc[n][2] + bias), y3 = gelu_tanh(bfhi(u1)) * (acc[n][3] + bias);
        *(GAS unsigned long long*)(op + 16 * n) = (unsigned long long)cvtpk(y0, y1) | ((unsigned long long)cvtpk(y2, y3) << 32); }
    __syncthreads();
}
__device__ __forceinline__ void mixer_phase(Frame& F, int l) {
    const int b = F.vcu;
    for (int u = b; u < (M / 128) * 4; u += F.G) pool_unit(F, l, u >> 2, u & 3);
    for (int u = b; u < (M / 128) * 12; u += F.G) sgu_unit(F, l, u / 12, u % 12);
    const float* cw = F.in[9] + (size_t)l * 3 * CONV_W;
    const int gt = b * (NWAVES * 64) + F.tid, NGT = F.G * NWAVES * 64;
    for (int item = gt; item < (M / 16) * (CONV_W / 8); item += NGT) { const int seg = item / (CONV_W / 8), c = (item - seg * (CONV_W / 8)) * 8, row0 = seg * 16, tl0 = row0 & (SEQ - 1);
        const bf16* p = F.PRJ + (size_t)row0 * PRJ_LD + c; bf16* o = F.MIX + (size_t)row0 * D + O_YB + c;
        float w0[8], w1[8], w2[8], z1[8], z2[8];
#pragma unroll
        for (int j = 0; j < 8; ++j) { w0[j] = cw[c + j]; w1[j] = cw[CONV_W + c + j]; w2[j] = cw[2 * CONV_W + c + j]; z1[j] = 0.f; z2[j] = 0.f; }
        if (tl0 >= 2) {
            const v4u q1 = *(const GAS v4u*)(p - PRJ_LD + P_Z), q2 = *(const GAS v4u*)(p - 2 * PRJ_LD + P_Z);
            z1[0] = bflo(q1.x); z1[1] = bfhi(q1.x); z1[2] = bflo(q1.y); z1[3] = bfhi(q1.y); z1[4] = bflo(q1.z); z1[5] = bfhi(q1.z); z1[6] = bflo(q1.w); z1[7] = bfhi(q1.w);
            z2[0] = bflo(q2.x); z2[1] = bfhi(q2.x); z2[2] = bflo(q2.y); z2[3] = bfhi(q2.y); z2[4] = bflo(q2.z); z2[5] = bfhi(q2.z); z2[6] = bflo(q2.w); z2[7] = bfhi(q2.w); }
#pragma unroll
        for (int rb = 0; rb < 16; rb += 8) { v4u gb[8], zz[8];
#pragma unroll
            for (int r = 0; r < 8; ++r) { const bf16* pr = p + (size_t)(rb + r) * PRJ_LD; gb[r] = *(const GAS v4u*)(pr + P_GB); zz[r] = *(const GAS v4u*)(pr + P_Z); }
#pragma unroll
            for (int r = 0; r < 8; ++r) {
                const float gbf[8] = {bflo(gb[r].x), bfhi(gb[r].x), bflo(gb[r].y), bfhi(gb[r].y), bflo(gb[r].z), bfhi(gb[r].z), bflo(gb[r].w), bfhi(gb[r].w)};
                const float z0[8] = {bflo(zz[r].x), bfhi(zz[r].x), bflo(zz[r].y), bfhi(zz[r].y), bflo(zz[r].z), bfhi(zz[r].z), bflo(zz[r].w), bfhi(zz[r].w)};
                float y[8];
#pragma unroll
                for (int j = 0; j < 8; ++j) { y[j] = gbf[j] * (w0[j] * z2[j] + w1[j] * z1[j] + w2[j] * z0[j]); z2[j] = z1[j]; z1[j] = z0[j]; }
                *(GAS v4u*)(o + (size_t)(rb + r) * D) = (v4u){cvtpk(y[0], y[1]), cvtpk(y[2], y[3]), cvtpk(y[4], y[5]), cvtpk(y[6], y[7])}; } }
    }
}
__device__ __forceinline__ void final_norm(Frame& F) {
    const int gw = F.vcu * NWAVES + F.wave, NGW = F.G * NWAVES;
    for (int m = gw; m < M; m += NGW) { const GAS v4u* xr = (const GAS v4u*)(F.XB + (size_t)m * D) + F.lane; v4u v[8]; float ss = 0.f;
#pragma unroll
        for (int j = 0; j < 8; ++j) { v[j] = xr[64 * j]; const float a0 = bflo(v[j].x), a1 = bfhi(v[j].x), a2 = bflo(v[j].y), a3 = bfhi(v[j].y), a4 = bflo(v[j].z), a5 = bfhi(v[j].z), a6 = bflo(v[j].w), a7 = bfhi(v[j].w);
            ss += ((a0 * a0 + a1 * a1) + (a2 * a2 + a3 * a3)) + ((a4 * a4 + a5 * a5) + (a6 * a6 + a7 * a7)); }
        const float rs = 1.0f / sqrtf(wave_sum(ss) * (1.0f / D) + NORM_EPS);
        GAS f32x4* o = (GAS f32x4*)(F.X + (size_t)m * D); const GAS f32x4* gn = (const GAS f32x4*)F.in[18];
#pragma unroll
        for (int j = 0; j < 8; ++j) { const int q = 2 * (F.lane + 64 * j); const f32x4 g0 = gn[q], g1 = gn[q + 1];
            o[q] = (f32x4){bflo(v[j].x) * rs * g0[0], bfhi(v[j].x) * rs * g0[1], bflo(v[j].y) * rs * g0[2], bfhi(v[j].y) * rs * g0[3]};
            o[q + 1] = (f32x4){bflo(v[j].z) * rs * g1[0], bfhi(v[j].z) * rs * g1[1], bflo(v[j].w) * rs * g1[2], bfhi(v[j].w) * rs * g1[3]}; } }
}
__device__ __forceinline__ void fill_rstd(Frame& F, LAS float* rtab, int pm) {
    if (F.tid < 256) rtab[F.tid] = pg8::row_rstd(F.PART, pm * 256 + F.tid, 1.0f / D, NORM_EPS);
    __syncthreads();
}

struct Args { const float* in[19]; float* out; unsigned char* ws; int ph_lo, ph_hi; };
static_assert(sizeof(Args) == 21 * 8 + 8, "Args has no holes");
__global__ void __launch_bounds__(NWAVES * 64, 2) mk_fwd(Args args) {
    extern __shared__ __attribute__((aligned(16))) unsigned char lds[];
    Frame F;
    F.lds = (LAS unsigned char*)lds;
    F.MISC = (volatile LAS unsigned*)(F.lds + MISC_OFF);
    F.tid = threadIdx.x; F.lane = F.tid & 63; F.wave = __builtin_amdgcn_readfirstlane(F.tid >> 6);
    F.G = gridDim.x; { const int bx = blockIdx.x; F.vcu = (F.G % 8 == 0) ? (bx % 8) * (F.G / 8) + bx / 8 : bx; }
    unsigned char* ws = args.ws;
    F.ctl = (gu32*)(ws + WS_CTL);
#pragma unroll
    for (int i = 0; i < 19; ++i) F.in[i] = args.in[i];
    F.X = args.out;
    F.W1T = (bf16*)(ws + WS_W1); F.WDT = (bf16*)(ws + WS_WD); F.WINT = (bf16*)(ws + WS_WIN); F.WOUTT = (bf16*)(ws + WS_WOUT); F.POOLWT = (bf16*)(ws + WS_POOLW); F.SGUWB = (bf16*)(ws + WS_SGUW);
    F.XB = (bf16*)(ws + WS_XB); F.HID = (bf16*)(ws + WS_HID); F.PRJ = (bf16*)(ws + WS_PROJ); F.MIX = (bf16*)(ws + WS_MIX); F.PART = (float*)(ws + WS_PART);
    if (F.tid < 64) ((LAS unsigned*)(F.lds + MISC_OFF))[F.tid] = 0u;
    __syncthreads();
    XcdBarrier bar = xcd_barrier_post((unsigned*)(F.ctl + CW_BAR), F.MISC + 8);
    const int lo = args.ph_lo, hi = args.ph_hi;
#define IN(k) (lo <= (k) && (k) < hi)
#define SEAM(k) do { if (IN(k) && IN((k) + 1)) xcd_barrier(bar); } while (0)
    LAS float* scr = (LAS float*)(F.lds + SCR_OFF);

    if (IN(0)) p0_prologue(F);
    SEAM(0);
    int ph = 1;
    for (int s = 0; s < 2 * DEPTH; ++s) {
        const int l = s >> 1, second = s & 1;
        const bf16* xb = F.XB; const bf16* hid = F.HID; const bf16* mix = F.MIX; int cblk = (int)blockIdx.x;
        asm volatile("" : "+s"(xb), "+s"(hid), "+s"(mix), "+s"(cblk));
        F.tid = threadIdx.x; asm volatile("" : "+v"(F.tid)); F.lane = F.tid & 63; F.wave = __builtin_amdgcn_readfirstlane(F.tid >> 6);
        asm volatile("" : "+s"(F.vcu));
        if (IN(ph)) { pg8::Gemm g{xb, F.W1T + (size_t)s * (2 * FF) * D, M, 2 * FF, D}; pg8::StaticOrder S; S.init(M, 2 * FF, F.G, cblk);
            pg8::Unit u0; u0.pm = 0; u0.pn = 0; (void)S.next(0, u0); fill_rstd(F, scr, u0.pm);
            pg8::EpiSwiglu E{F.HID, FF, F.PART, 1.0f / D, NORM_EPS, scr, u0.pm};
            pg8::gemm_phase<pg8::EpiSwiglu, pg8::StaticOrder, PG8_ALIGN, PG8_SP2>(F.lds + RING_OFF, g, S, E);
#if MK_TAILFILL
            { constexpr int REM = ((M / 256) * (2 * FF / 256)) % 256;
                if (REM > 0 && F.G == 256 && cblk >= REM) { const int wr_ = (cblk - REM) * NWAVES + F.wave, nw_ = (256 - REM) * NWAVES;
                    if (!second) convert_items(F, l, IT_GU, IT_A_END, wr_, nw_); else if (l + 1 < DEPTH) convert_items(F, l + 1, 0, IT_GU, wr_, nw_); } }
#endif
        }
        SEAM(ph); ++ph;
        if (IN(ph)) { pg8::Gemm g{hid, F.WDT + (size_t)s * D * FF, M, D, FF}; pg8::StaticOrder S; S.init(M, D, F.G, cblk);
            pg8::EpiResid E{F.XB, F.PART, D, 0.5f, scr};
            pg8::gemm_phase<pg8::EpiResid, pg8::StaticOrder, PG8_ALIGN, PG8_SP2>(F.lds + RING_OFF, g, S, E); }
        SEAM(ph); ++ph;
        if (!second) {
            if (IN(ph)) { pg8::Gemm g{xb, F.WINT + (size_t)l * PROJ * D, M, PROJ, D}; pg8::StaticOrder S; S.init(M, PROJ, F.G, cblk);
                pg8::Unit u0; u0.pm = 0; u0.pn = 0; (void)S.next(0, u0); fill_rstd(F, scr, u0.pm);
                pg8::EpiScaleBf16 E{F.PRJ, PRJ_LD, F.PART, 1.0f / D, NORM_EPS, scr, u0.pm, Z_LO, Z_HI};
                pg8::gemm_phase<pg8::EpiScaleBf16, pg8::StaticOrder, PG8_ALIGN, PG8_SP2>(F.lds + RING_OFF, g, S, E);
#if MK_TAILFILL
                { constexpr int REM = ((M / 256) * (PROJ / 256)) % 256;
                    if (REM > 0 && F.G == 256 && cblk >= REM) convert_items(F, l, IT_A_END, PER_LAYER, (cblk - REM) * NWAVES + F.wave, (256 - REM) * NWAVES); }
#endif
            }
            SEAM(ph); ++ph;
            if (IN(ph)) mixer_phase(F, l);
            SEAM(ph); ++ph;
            if (IN(ph)) { pg8::Gemm g{mix, F.WOUTT + (size_t)l * D * D, M, D, D}; pg8::StaticOrder S; S.init(M, D, F.G, cblk);
                pg8::EpiResid E{F.XB, F.PART, D, 1.0f, scr};
                pg8::gemm_phase<pg8::EpiResid, pg8::StaticOrder, PG8_ALIGN, PG8_SP2>(F.lds + RING_OFF, g, S, E); }
            SEAM(ph); ++ph;
        }
    }
    F.tid = threadIdx.x; asm volatile("" : "+v"(F.tid)); F.lane = F.tid & 63; F.wave = __builtin_amdgcn_readfirstlane(F.tid >> 6);
    if (IN(ph)) final_norm(F);
#undef IN
#undef SEAM
}

extern "C" void kernel_launch(void* const* d_in, const int* in_sizes, int n_in, void* d_out, int out_size, void* d_ws, size_t ws_size, hipStream_t stream) {
    static int grid = 0;
    if (grid == 0) {
        if (n_in != 19 || in_sizes[0] != M * D || out_size != M * D || ws_size < WS_END) { fprintf(stderr, "kernel_launch: built for 19 inputs, x and out of %d floats, >= %zu bytes of workspace; got n_in %d, in0 %d, out %d, ws %zu; nothing launched\n", M * D, (size_t)WS_END, n_in, n_in > 0 ? in_sizes[0] : -1, out_size, ws_size); grid = -1; return; }
        int dev = 0, cus = 0, per_cu = 0;
        if (hipGetDevice(&dev) != hipSuccess || hipDeviceGetAttribute(&cus, hipDeviceAttributeMultiprocessorCount, dev) != hipSuccess) { fprintf(stderr, "kernel_launch: hipGetDevice / hipDeviceGetAttribute failed; nothing launched\n"); grid = -1; return; }
        if (hipFuncSetAttribute((const void*)mk_fwd, hipFuncAttributeMaxDynamicSharedMemorySize, LDS_BYTES) != hipSuccess) { fprintf(stderr, "kernel_launch: hipFuncSetAttribute failed\n"); grid = -1; return; }
        if (hipOccupancyMaxActiveBlocksPerMultiprocessor(&per_cu, (const void*)mk_fwd, NWAVES * 64, LDS_BYTES) != hipSuccess || per_cu < 1) fprintf(stderr, "kernel_launch: note: occupancy query reports %d workgroups per CU; launching one per CU anyway\n", per_cu);
        (void)hipGetLastError();
        grid = cus;
    }
    if (grid < 0) return;
    if (hipMemsetAsync((char*)d_ws + WS_CTL, 0, CTL_ZERO_BYTES, stream) != hipSuccess) { fprintf(stderr, "kernel_launch: hipMemsetAsync of the control words failed; nothing launched\n"); return; }
    Args a{};
    for (int i = 0; i < 19; ++i) a.in[i] = (const float*)d_in[i];
    a.out = (float*)d_out; a.ws = (unsigned char*)d_ws;
#if MK_PER_PHASE
    for (int p = 0; p < NPHASES; ++p) { a.ph_lo = p; a.ph_hi = p + 1; hipLaunchKernelGGL(mk_fwd, dim3(grid), dim3(NWAVES * 64), LDS_BYTES, stream, a); }
#else
    a.ph_lo = 0; a.ph_hi = NPHASES;
    hipLaunchKernelGGL(mk_fwd, dim3(grid), dim3(NWAVES * 64), LDS_BYTES, stream, a);
#endif
    const hipError_t le = hipPeekAtLastError();
    if (le != hipSuccess) fprintf(stderr, "kernel_launch: launch failed: %s (grid %d x %d threads, %d B LDS)\n", hipGetErrorName(le), grid, NWAVES * 64, LDS_BYTES);
}
```

```cpp
#include <hip/hip_runtime.h>
#include <cstdio>
#include <cstdint>
#include <cstddef>
namespace pg8 {
#define PG8_LAS __attribute__((address_space(3)))
typedef unsigned short bf16_t;
typedef short bf16x8 __attribute__((ext_vector_type(8)));
typedef float f32x4 __attribute__((ext_vector_type(4)));
typedef unsigned u32x4 __attribute__((ext_vector_type(4)));
constexpr int BM = 256, BK = 64, HALF = 128, HTB = HALF * BK * 2  , STAGE_BYTES = 8 * HTB, NXCD = 8, WGM = 4;

__host__ __device__ __forceinline__ int lds_byte(int r, int c) { const int st = (r >> 4) * 2 + (c >> 5), rr = r & 15, cc = c & 31, ob = rr * 64 + cc * 2; return st * 1024 + (ob ^ (((ob >> 9) & 1) << 5)); }
__host__ __device__ __forceinline__ void stage_rc(int b, int& R, int& C) { const int st = b / 1024, sb = b % 1024, swz = sb ^ (((sb >> 9) & 1) << 5); R = (st >> 1) * 16 + swz / 64; C = (st & 1) * 32 + (swz % 64) / 2; }
__host__ __device__ __forceinline__ int perm32(int rho) { const int n = rho >> 4, i = rho & 15; return 8 * (i >> 2) + 4 * n + (i & 3); }

struct Unit { int pm, pn; };
struct Gemm { const bf16_t* A; const bf16_t* Bt; int M, N, K; };

struct StaticOrder {
    int nM, nN, nwg, G, c;
    __host__ __device__ void init(int M, int N, int G_, int c_) { nM = M / BM; nN = N / BM; nwg = nM * nN; G = G_; c = c_; }
    __host__ __device__ bool next(int i, Unit& u) const {
        const long L = (long)i * G + c; if (L >= nwg) return false;
        int wgid = (int)L; { const int q = nwg / NXCD, r = nwg % NXCD, xcd = wgid % NXCD, off = wgid / NXCD; wgid = (xcd < r ? xcd * (q + 1) : r * (q + 1) + (xcd - r) * q) + off; }
        const int nig = WGM * nN, gid = wgid / nig, fm = gid * WGM, gsz = (nM - fm) < WGM ? (nM - fm) : WGM;
        u.pm = fm + ((wgid % nig) % gsz); u.pn = (wgid % nig) / gsz; return true;
    }
    __device__ __forceinline__ void a_ready(const Unit&) const {}
    __device__ __forceinline__ void done(const Unit&) const {}
};
typedef float f32x2 __attribute__((ext_vector_type(2)));
typedef __bf16 bf16x2_t __attribute__((ext_vector_type(2)));
__device__ __forceinline__ unsigned cvt_pk_bf16(float lo, float hi) { const f32x2 v = {lo, hi}; return __builtin_bit_cast(unsigned, __builtin_convertvector(v, bf16x2_t)); }
typedef unsigned u32x2 __attribute__((ext_vector_type(2)));
constexpr int NPART = 16;
__device__ __forceinline__ float row_rstd(const float* part, int row, float inv_d, float eps) {
    const f32x4* p = (const f32x4*)(part + (size_t)row * NPART);
    const f32x4 a = p[0], b = p[1], c = p[2], d = p[3];
    const f32x4 s = (a + b) + (c + d);
    return __builtin_amdgcn_rsqf(((s[0] + s[1]) + (s[2] + s[3])) * inv_d + eps);
}
__device__ __forceinline__ float swiglu1(float g, float u) { const float e = __builtin_amdgcn_exp2f(-1.44269504089f * g); return g * u * __builtin_amdgcn_rcpf(1.0f + e); }

struct EpiSwiglu {
    static constexpr bool PERM = true, AFTER_DRAIN = false;
    bf16_t* H; int ldh; const float* part; float inv_d, eps; const PG8_LAS float* rtab; int pm0;
    __device__ __forceinline__ void operator()(const f32x4 (&acc)[2][2][4][2], const Unit& u, int wr, int wc, int fr, int fq) const {
        const int row0 = u.pm * BM + wr * 64 + fr, col0 = u.pn * HALF + wc * 32 + 8 * fq;
#pragma unroll
        for (int ai = 0; ai < 2; ++ai)
#pragma unroll
            for (int m = 0; m < 4; ++m) { const int row = row0 + ai * HALF + m * 16; const float rs = (u.pm == pm0) ? rtab[ai * HALF + wr * 64 + m * 16 + fr] : row_rstd(part, row, inv_d, eps);
                const f32x4 g0 = acc[ai][0][m][0] * rs, g1 = acc[ai][0][m][1] * rs, u0 = acc[ai][1][m][0] * rs, u1 = acc[ai][1][m][1] * rs;
                u32x4 w; w.x = cvt_pk_bf16(swiglu1(g0[0], u0[0]), swiglu1(g0[1], u0[1])); w.y = cvt_pk_bf16(swiglu1(g0[2], u0[2]), swiglu1(g0[3], u0[3]));
                w.z = cvt_pk_bf16(swiglu1(g1[0], u1[0]), swiglu1(g1[1], u1[1])); w.w = cvt_pk_bf16(swiglu1(g1[2], u1[2]), swiglu1(g1[3], u1[3]));
                *(u32x4*)(H + (size_t)row * ldh + col0) = w;
                if (m & 1) asm volatile("" ::: "memory"); }
    }
};
struct EpiScaleBf16 {
    static constexpr bool PERM = true, AFTER_DRAIN = false;
    bf16_t* O; int ldo; const float* part; float inv_d, eps; const PG8_LAS float* rtab; int pm0; int zlo, zhi;
    __device__ __forceinline__ void operator()(const f32x4 (&acc)[2][2][4][2], const Unit& u, int wr, int wc, int fr, int fq) const {
        const bool zt = u.pn >= zlo && u.pn < zhi;
        const int cb = u.pn < zlo ? u.pn * BM : zt ? zlo * BM + (u.pn - zlo) * HALF : u.pn * BM - (zhi - zlo) * HALF;
        const int row0 = u.pm * BM + wr * 64 + fr, col0 = cb + wc * 32 + 8 * fq;
#pragma unroll
        for (int ai = 0; ai < 2; ++ai)
#pragma unroll
            for (int m = 0; m < 4; ++m) { const int row = row0 + ai * HALF + m * 16; const float rs = (u.pm == pm0) ? rtab[ai * HALF + wr * 64 + m * 16 + fr] : row_rstd(part, row, inv_d, eps);
                bf16_t* rowp = O + (size_t)row * ldo + col0;
                if (zt) { const float r2 = rs * rs; const f32x4 v0 = acc[ai][0][m][0] * acc[ai][1][m][0] * r2, v1 = acc[ai][0][m][1] * acc[ai][1][m][1] * r2;
                    u32x4 w; w.x = cvt_pk_bf16(v0[0], v0[1]); w.y = cvt_pk_bf16(v0[2], v0[3]); w.z = cvt_pk_bf16(v1[0], v1[1]); w.w = cvt_pk_bf16(v1[2], v1[3]);
                    *(u32x4*)rowp = w; }
                else {
#pragma unroll
                for (int bj = 0; bj < 2; ++bj) { const f32x4 v0 = acc[ai][bj][m][0] * rs, v1 = acc[ai][bj][m][1] * rs;
                    u32x4 w; w.x = cvt_pk_bf16(v0[0], v0[1]); w.y = cvt_pk_bf16(v0[2], v0[3]); w.z = cvt_pk_bf16(v1[0], v1[1]); w.w = cvt_pk_bf16(v1[2], v1[3]);
                    *(u32x4*)(rowp + bj * HALF) = w; } }
                if (m & 1) asm volatile("" ::: "memory"); }
    }
};
__device__ __forceinline__ float bf_lo(unsigned w) { return __builtin_bit_cast(float, w << 16); }
__device__ __forceinline__ float bf_hi(unsigned w) { return __builtin_bit_cast(float, w & 0xffff0000u); }
struct EpiResid {
    static constexpr bool PERM = true, AFTER_DRAIN = false;
    bf16_t* XB; float* part; int ld; float alpha; PG8_LAS float* scr;
    __device__ __forceinline__ void operator()(const f32x4 (&acc)[2][2][4][2], const Unit& u, int wr, int wc, int fr, int fq) const {
        const int row0 = u.pm * BM + wr * 64 + fr, col0 = u.pn * BM + wc * 32 + 8 * fq;
        u32x4 xin[2][4][2];
#pragma unroll
        for (int ai = 0; ai < 2; ++ai)
#pragma unroll
            for (int m = 0; m < 4; ++m)
#pragma unroll
                for (int bj = 0; bj < 2; ++bj) xin[ai][m][bj] = *(const u32x4*)(XB + (size_t)(row0 + ai * HALF + m * 16) * ld + col0 + bj * HALF);
#pragma unroll
        for (int ai = 0; ai < 2; ++ai)
#pragma unroll
            for (int m = 0; m < 4; ++m) { const size_t off = (size_t)(row0 + ai * HALF + m * 16) * ld + col0; float ss = 0.f;
#pragma unroll
                for (int bj = 0; bj < 2; ++bj) { const u32x4 x = xin[ai][m][bj]; const f32x4 a0 = acc[ai][bj][m][0] * alpha, a1 = acc[ai][bj][m][1] * alpha;
                    u32x4 w; w.x = cvt_pk_bf16(bf_lo(x.x) + a0[0], bf_hi(x.x) + a0[1]); w.y = cvt_pk_bf16(bf_lo(x.y) + a0[2], bf_hi(x.y) + a0[3]);
                    w.z = cvt_pk_bf16(bf_lo(x.z) + a1[0], bf_hi(x.z) + a1[1]); w.w = cvt_pk_bf16(bf_lo(x.w) + a1[2], bf_hi(x.w) + a1[3]);
                    *(u32x4*)(XB + off + bj * HALF) = w;
                    const float r0 = bf_lo(w.x), r1 = bf_hi(w.x), r2 = bf_lo(w.y), r3 = bf_hi(w.y), r4 = bf_lo(w.z), r5 = bf_hi(w.z), r6 = bf_lo(w.w), r7 = bf_hi(w.w);
                    ss += ((r0 * r0 + r1 * r1) + (r2 * r2 + r3 * r3)) + ((r4 * r4 + r5 * r5) + (r6 * r6 + r7 * r7)); }
                ss += __shfl_xor(ss, 16); ss += __shfl_xor(ss, 32);
                if (fq == 0) scr[(ai * HALF + wr * 64 + m * 16 + fr) * 4 + wc] = ss; }
        asm volatile("s_waitcnt lgkmcnt(0)" ::: "memory"); __builtin_amdgcn_s_barrier(); asm volatile("" ::: "memory");
        const int lane = fq * 16 + fr;
        if (lane < 32) { const int rl = (wc >> 1) * HALF + wr * 64 + (wc & 1) * 32 + lane;
            const f32x4 v = *(const PG8_LAS f32x4*)(scr + rl * 4);
            part[(size_t)(u.pm * BM + rl) * NPART + u.pn] = (v[0] + v[1]) + (v[2] + v[3]); }
    }
};

template <class Epi, class Sched, bool ALIGN_EPI = false, bool SP2 = false>
__device__ __forceinline__ void gemm_phase(PG8_LAS unsigned char* lds, const Gemm g, const Sched& S, const Epi& E) {
    int tid_ = threadIdx.x; asm volatile("" : "+v"(tid_));
    const int tid = tid_, wid = __builtin_amdgcn_readfirstlane(tid >> 6), lane = tid & 63, wr = wid >> 2, wc = wid & 3, fr = lane & 15, fq = lane >> 4;
    const int K = g.K, nt = K / BK;
    unsigned voffA[2], voffB[2];
#pragma unroll
    for (int i = 0; i < 2; ++i) { int R, C; stage_rc(tid * 16 + i * 8192, R, C); const int Rb = Epi::PERM ? ((R & ~31) + perm32(R & 31)) : R;
        voffA[i] = (unsigned)(R * K + C) * 2u; voffB[i] = (unsigned)(Rb * K + C) * 2u; }
    const size_t kstep = (size_t)(BK * 2);
    const size_t hstep = (size_t)HALF * K * 2;
    const size_t tstep = 2 * hstep;
    const unsigned ldsw = (unsigned)wid * 1024u;
    const int aoff = lds_byte(wr * 64 + fr, fq * 8), boff = lds_byte(wc * 32 + fr, fq * 8);
#define PG8_SA(b, h) (((b) * 2 + (h)) * HTB)
#define PG8_SB(b, h) ((4 + (b) * 2 + (h)) * HTB)
#define PG8_STAGE(bufoff, gbase, voff) do { _Pragma("unroll") for (int _i = 0; _i < 2; ++_i) \
        __builtin_amdgcn_global_load_lds((const unsigned*)((const char*)(gbase) + (voff)[_i]), (PG8_LAS unsigned*)(lds + (bufoff) + ldsw + _i * 8192), 16, 0, 0); } while (0)
#define PG8_LDA(dst, b, h) do { _Pragma("unroll") for (int m = 0; m < 4; ++m) _Pragma("unroll") for (int k = 0; k < 2; ++k) dst[m][k] = *(const PG8_LAS bf16x8*)(lds + PG8_SA(b, h) + aoff + m * 2048 + k * 1024); } while (0)
#define PG8_LDB(dst, b, h) do { _Pragma("unroll") for (int n = 0; n < 2; ++n) _Pragma("unroll") for (int k = 0; k < 2; ++k) dst[n][k] = *(const PG8_LAS bf16x8*)(lds + PG8_SB(b, h) + boff + n * 2048 + k * 1024); } while (0)
#define PG8_MMA(ai, bj, At, Bt) do { __builtin_amdgcn_s_setprio(1); _Pragma("unroll") for (int m = 0; m < 4; ++m) _Pragma("unroll") for (int n = 0; n < 2; ++n) _Pragma("unroll") for (int k = 0; k < 2; ++k) \
        acc[ai][bj][m][n] = __builtin_amdgcn_mfma_f32_16x16x32_bf16(Bt[n][k], At[m][k], acc[ai][bj][m][n], 0, 0, 0); __builtin_amdgcn_s_setprio(0); } while (0)
#define PG8_WAIT_V(n) asm volatile("s_waitcnt vmcnt(" #n ")" ::: "memory")
#define PG8_WAIT_L(n) asm volatile("s_waitcnt lgkmcnt(" #n ")" ::: "memory")
#define PG8_BAR __builtin_amdgcn_s_barrier()
#define PG8_SCHED __builtin_amdgcn_sched_barrier(0)
    Unit cur, nxt; int ui = 0;
    if (!S.next(0, cur)) return;
    f32x4 acc[2][2][4][2];
#pragma unroll
    for (int a = 0; a < 2; ++a)
#pragma unroll
        for (int b = 0; b < 2; ++b)
#pragma unroll
            for (int m = 0; m < 4; ++m)
#pragma unroll
                for (int n = 0; n < 2; ++n) acc[a][b][m][n] = (f32x4){0.f, 0.f, 0.f, 0.f};
    bf16x8 At[4][2], B0[2][2], B1[2][2];
    const char* cA = (const char*)g.A + (size_t)cur.pm * tstep; const char* cB = (const char*)g.Bt + (size_t)cur.pn * tstep;
    S.a_ready(cur);
    if constexpr (SP2) {
        PG8_STAGE(PG8_SB(0, 0), cB, voffB); PG8_STAGE(PG8_SB(0, 1), cB + hstep, voffB); PG8_STAGE(PG8_SA(0, 0), cA, voffA); PG8_STAGE(PG8_SA(0, 1), cA + hstep, voffA);
        if (wr == 1) PG8_BAR;
        PG8_WAIT_V(2); PG8_BAR;
        PG8_STAGE(PG8_SB(1, 0), cB + kstep, voffB); PG8_STAGE(PG8_SA(1, 0), cA + kstep, voffA); PG8_STAGE(PG8_SB(1, 1), cB + hstep + kstep, voffB);
        PG8_WAIT_V(6); PG8_BAR;
    } else {
        PG8_STAGE(PG8_SB(0, 0), cB, voffB); PG8_STAGE(PG8_SA(0, 0), cA, voffA); PG8_STAGE(PG8_SB(0, 1), cB + hstep, voffB); PG8_STAGE(PG8_SA(0, 1), cA + hstep, voffA);
        if (wr == 1) PG8_BAR;
        PG8_WAIT_V(4); PG8_BAR;
        PG8_STAGE(PG8_SB(1, 0), cB + kstep, voffB); PG8_STAGE(PG8_SA(1, 0), cA + kstep, voffA); PG8_STAGE(PG8_SB(1, 1), cB + hstep + kstep, voffB);
        PG8_WAIT_V(6); PG8_BAR;
    }
    for (;;) {
        const bool has_next = S.next(ui + 1, nxt);
        const char* nA = has_next ? (const char*)g.A + (size_t)nxt.pm * tstep : cA; const char* nB = has_next ? (const char*)g.Bt + (size_t)nxt.pn * tstep : cB;
        for (int t = 0; t < nt; t += 2) {
            const bool last = (t == nt - 2);
            const char* a1 = cA + (size_t)(t + 1) * kstep;
            const char* a2 = last ? nA : cA + (size_t)(t + 2) * kstep; const char* b2 = last ? nB : cB + (size_t)(t + 2) * kstep;
            const char* a3 = a2 + kstep; const char* b3 = b2 + kstep;
            if (last && has_next) S.a_ready(nxt);
            if constexpr (SP2) {
            PG8_LDB(B0, 0, 0); PG8_LDB(B1, 0, 1); PG8_SCHED; PG8_LDA(At, 0, 0); PG8_STAGE(PG8_SA(1, 1), a1 + hstep, voffA);
            PG8_WAIT_V(8); PG8_WAIT_L(0); PG8_BAR; PG8_MMA(0, 0, At, B0); PG8_MMA(0, 1, At, B1); PG8_BAR; PG8_SCHED;
            PG8_LDA(At, 0, 1); PG8_STAGE(PG8_SB(0, 0), b2, voffB); PG8_STAGE(PG8_SB(0, 1), b2 + hstep, voffB); PG8_STAGE(PG8_SA(0, 0), a2, voffA);
            PG8_WAIT_V(8); PG8_WAIT_L(0); PG8_BAR; PG8_MMA(1, 0, At, B0); PG8_MMA(1, 1, At, B1); PG8_BAR; PG8_SCHED;
            PG8_LDB(B0, 1, 0); PG8_LDB(B1, 1, 1); PG8_SCHED; PG8_LDA(At, 1, 0); PG8_STAGE(PG8_SA(0, 1), a2 + hstep, voffA);
            PG8_WAIT_V(8); PG8_WAIT_L(0); PG8_BAR; PG8_MMA(0, 0, At, B0); PG8_MMA(0, 1, At, B1); PG8_BAR; PG8_SCHED;
            PG8_LDA(At, 1, 1); PG8_STAGE(PG8_SB(1, 0), b3, voffB); PG8_STAGE(PG8_SB(1, 1), b3 + hstep, voffB); PG8_STAGE(PG8_SA(1, 0), a3, voffA);
            PG8_WAIT_V(8); PG8_WAIT_L(0); PG8_BAR; PG8_MMA(1, 0, At, B0); PG8_MMA(1, 1, At, B1); PG8_BAR; PG8_SCHED;
            } else {
            PG8_LDB(B0, 0, 0); PG8_SCHED; PG8_LDA(At, 0, 0); PG8_STAGE(PG8_SA(1, 1), a1 + hstep, voffA);
            PG8_WAIT_L(8); PG8_BAR; PG8_WAIT_L(0); PG8_MMA(0, 0, At, B0); PG8_BAR; PG8_SCHED;
            PG8_LDB(B1, 0, 1); PG8_STAGE(PG8_SB(0, 0), b2, voffB);
            PG8_BAR; PG8_WAIT_L(0); PG8_MMA(0, 1, At, B1); PG8_BAR;
            PG8_LDA(At, 0, 1); PG8_STAGE(PG8_SA(0, 0), a2, voffA);
            PG8_BAR; PG8_WAIT_L(0); PG8_MMA(1, 0, At, B0); PG8_BAR; PG8_SCHED;
            PG8_STAGE(PG8_SB(0, 1), b2 + hstep, voffB);
            PG8_WAIT_V(6); PG8_BAR; PG8_MMA(1, 1, At, B1); PG8_BAR;
            PG8_LDB(B0, 1, 0); PG8_SCHED; PG8_LDA(At, 1, 0); PG8_STAGE(PG8_SA(0, 1), a2 + hstep, voffA);
            PG8_WAIT_L(8); PG8_BAR; PG8_WAIT_L(0); PG8_MMA(0, 0, At, B0); PG8_BAR; PG8_SCHED;
            PG8_LDB(B1, 1, 1); PG8_STAGE(PG8_SB(1, 0), b3, voffB);
            PG8_BAR; PG8_WAIT_L(0); PG8_MMA(0, 1, At, B1); PG8_BAR;
            PG8_LDA(At, 1, 1); PG8_STAGE(PG8_SA(1, 0), a3, voffA);
            PG8_BAR; PG8_WAIT_L(0); PG8_MMA(1, 0, At, B0); PG8_BAR; PG8_SCHED;
            PG8_STAGE(PG8_SB(1, 1), b3 + hstep, voffB);
            PG8_WAIT_V(6); PG8_BAR; PG8_MMA(1, 1, At, B1); PG8_BAR;
            }
        }
        if constexpr (ALIGN_EPI) { if (wr == 0) PG8_BAR; }
        if constexpr (!Epi::AFTER_DRAIN) { E(acc, cur, wr, wc, fr, fq); S.done(cur); }
        if (!has_next) break;
#pragma unroll
        for (int a = 0; a < 2; ++a)
#pragma unroll
            for (int b = 0; b < 2; ++b)
#pragma unroll
                for (int m = 0; m < 4; ++m)
#pragma unroll
                    for (int n = 0; n < 2; ++n) acc[a][b][m][n] = (f32x4){0.f, 0.f, 0.f, 0.f};
        cur = nxt; cA = nA; cB = nB; ++ui;
        if constexpr (ALIGN_EPI) { if (wr == 1) PG8_BAR; }
    }
    PG8_WAIT_V(0);
    if constexpr (!ALIGN_EPI) { if (wr == 0) PG8_BAR; }
    PG8_BAR;
    if constexpr (Epi::AFTER_DRAIN) { E.fused(acc, cur, wr, wc, fr, fq, lds, wid, lane); S.done(cur); }
#undef PG8_SA
#undef PG8_SB
#undef PG8_STAGE
#undef PG8_LDA
#undef PG8_LDB
#undef PG8_MMA
#undef PG8_WAIT_V
#undef PG8_WAIT_L
#undef PG8_BAR
#undef PG8_SCHED
}
}
#ifndef PG8_SP2
#define PG8_SP2 true
#endif
#ifndef PG8_ALIGN
#define PG8_ALIGN true
#endif
constexpr int NWAVES = 8;
#ifndef MK_TAILFILL
#define MK_TAILFILL 1
#endif
#ifndef MK_PER_PHASE
#define MK_PER_PHASE 0
#endif

constexpr int BATCH = 4, SEQ = 2048, D = 4096, DEPTH = 4, FF = 5632;
constexpr int M = BATCH * SEQ;
constexpr int POOL_W = 1024, CONV_W = 1536, SGU_W = 1536, PROJ = 8704;
constexpr int C_A = 0, C_GB = 1024, C_GC = 2560, C_XC = 4096, C_U = 5632, C_V = 7168;
constexpr int PRJ_LD = PROJ - CONV_W, P_A = 0, P_GB = 1024, P_Z = 2560, P_U = 4096, P_V = 5632, Z_LO = C_GC / 256, Z_HI = Z_LO + CONV_W / 128;
static_assert(C_GC % 256 == 0 && CONV_W % 128 == 0 && C_XC == C_GC + CONV_W && C_U == C_XC + CONV_W && Z_HI * 256 == C_U, "z tiles");
constexpr int O_YA = 0, O_YB = 1024, O_YC = 2560;
constexpr float NORM_EPS = 1e-6f, LN_EPS = 1e-5f;
constexpr int NPHASES = 2 + 7 * DEPTH;

constexpr size_t MiB = 1u << 20;
constexpr size_t WS_CTL = 0, CTL_ZERO_BYTES = 1 * MiB;
constexpr size_t SZ_W1 = (size_t)2 * FF * D * 2;
constexpr size_t SZ_WD = (size_t)D * FF * 2;
constexpr size_t SZ_WIN = (size_t)PROJ * D * 2, SZ_WOUT = (size_t)D * D * 2;
constexpr size_t WS_W1 = 2 * MiB;
constexpr size_t WS_WD = WS_W1 + 2 * DEPTH * SZ_W1;
constexpr size_t WS_WIN = WS_WD + 2 * DEPTH * SZ_WD;
constexpr size_t WS_WOUT = WS_WIN + DEPTH * SZ_WIN;
constexpr size_t WS_POOLW = WS_WOUT + DEPTH * SZ_WOUT;
constexpr size_t WS_SGUW = WS_POOLW + (size_t)DEPTH * 4 * 256 * 256 * 2;
constexpr size_t WS_XB = WS_SGUW + (size_t)DEPTH * 12 * 128 * 128 * 2;
constexpr size_t WS_HID = WS_XB + (size_t)M * D * 2;
constexpr size_t WS_PROJ = WS_HID + (size_t)M * FF * 2;
constexpr size_t WS_MIX = WS_PROJ + (size_t)M * PROJ * 2;
constexpr size_t WS_PART = WS_MIX + (size_t)M * D * 2;
constexpr size_t WS_END = WS_PART + (size_t)M * 16 * 4;
static_assert(WS_W1 % 256 == 0 && WS_WD % 256 == 0 && WS_WIN % 256 == 0 && WS_WOUT % 256 == 0 && WS_POOLW % 256 == 0 && WS_SGUW % 256 == 0 && WS_XB % 256 == 0 && WS_HID % 256 == 0 && WS_PROJ % 256 == 0 && WS_MIX % 256 == 0 && WS_PART % 256 == 0, "d_ws map alignment");
constexpr int CW_BAR = 4096;

constexpr int RING_OFF = 0, RING_BYTES = 131072;
constexpr int SCR_OFF = RING_BYTES;
constexpr int LDS_BYTES = 147456;
constexpr int MISC_OFF = LDS_BYTES - 256;
static_assert(SCR_OFF + 4096 <= MISC_OFF, "LDS map");

#define GAS __attribute__((address_space(1)))
#define LAS __attribute__((address_space(3)))
typedef unsigned short bf16;
typedef unsigned v4u __attribute__((ext_vector_type(4)));
typedef float f32x4 __attribute__((ext_vector_type(4)));
typedef short bf16x8 __attribute__((ext_vector_type(8)));
typedef GAS unsigned gu32;
typedef GAS unsigned long long gu64;
#define RLX_AGENT __ATOMIC_RELAXED, __HIP_MEMORY_SCOPE_AGENT
#define LDS_WAIT() asm volatile("s_waitcnt lgkmcnt(0)" ::: "memory")
#define VM_WAIT() asm volatile("s_waitcnt vmcnt(0)" ::: "memory")
__device__ __forceinline__ unsigned long long rt() { return __builtin_amdgcn_s_memrealtime(); }
__device__ __forceinline__ unsigned f2bf(float f) { unsigned u = __builtin_bit_cast(unsigned, f); return (u + 0x7fffu + ((u >> 16) & 1u)) >> 16; }
__device__ __forceinline__ unsigned pk2(float lo, float hi) { return f2bf(lo) | (f2bf(hi) << 16); }
#define XB_TMO      128
#define XB_XCNT(j)  (256  + 64 * (j))
#define XB_XSUB(j)  (1280 + 64 * (j))
#define XB_XGEN(j)  (2304 + 64 * (j))
#define XB_TOP      3328
#define XB_TOPGEN   3392
#define XCD_BAR_WORDS 3456
#define XB_SPIN_CAP (1u << 18)

__device__ __forceinline__ unsigned xb_ld(unsigned* p)              { return __hip_atomic_load(p, __ATOMIC_RELAXED, __HIP_MEMORY_SCOPE_AGENT); }
__device__ __forceinline__ unsigned xb_add(unsigned* p, unsigned v) { return __hip_atomic_fetch_add(p, v, __ATOMIC_RELAXED, __HIP_MEMORY_SCOPE_AGENT); }
__device__ __forceinline__ unsigned xb_xcc_id() { return (unsigned)__builtin_amdgcn_s_getreg((3 << 11) | 20) & 0xFu; }
#define XB_SPIN(cond, bar) do { unsigned _sp = 0; while (cond) { __builtin_amdgcn_s_sleep(1); \
    if ((++_sp & 255u) == 0u) { if (xb_ld(&(bar)[XB_TMO])) break; if (_sp > XB_SPIN_CAP) { atomicAdd(&(bar)[XB_TMO], 1u); break; } } } } while (0)

struct XcdBarrier {
    unsigned* bar; unsigned x;
    volatile LAS unsigned* st;
};

__device__ __forceinline__ XcdBarrier xcd_barrier_post(unsigned* bar, volatile LAS unsigned* st) {
    XcdBarrier b; b.bar = bar; b.x = xb_xcc_id(); b.st = st;
    if (threadIdx.x == 0) (void)xb_add(&bar[XB_XCNT(b.x)], 1u);
    return b;
}
__device__ __forceinline__ void xcd_barrier_complete(unsigned* bar, unsigned x, unsigned& nloc, unsigned& nx) {
    const unsigned G = gridDim.x * gridDim.y * gridDim.z;
    unsigned sum, cnt, mine, sp = 0u;
    for (;;) {
        sum = 0u; cnt = 0u; mine = 0u;
#pragma unroll
        for (unsigned j = 0; j < 16; ++j) { const unsigned c = xb_ld(&bar[XB_XCNT(j)]); sum += c; cnt += (c > 0u) ? 1u : 0u; mine = (j == x) ? c : mine; }
        if (sum == G) break;
        __builtin_amdgcn_s_sleep(1);
        if ((++sp & 255u) == 0u) { if (xb_ld(&bar[XB_TMO])) break; if (sp > XB_SPIN_CAP) { atomicAdd(&bar[XB_TMO], 1u); break; } }
    }
    nloc = mine > 0u ? mine : 1u; nx = cnt > 0u ? cnt : 1u;
}

__device__ __forceinline__ void xcd_barrier(const XcdBarrier& b) {
    asm volatile("s_waitcnt vmcnt(0)" ::: "memory");
    __syncthreads();
    if (threadIdx.x == 0) {
        unsigned* bar = b.bar;
        __builtin_amdgcn_s_waitcnt(0);
        unsigned nloc = b.st[0], nx = b.st[1];
        if (nloc == 0u) { xcd_barrier_complete(bar, b.x, nloc, nx); b.st[0] = nloc; b.st[1] = nx; }
        const unsigned old = xb_add(&bar[XB_XSUB(b.x)], 1u);
        const unsigned gen = old / nloc;
        if (old + 1u == (gen + 1u) * nloc) {
            __builtin_amdgcn_fence(__ATOMIC_RELEASE, "agent");
            asm volatile("s_waitcnt vmcnt(0)" ::: "memory");
            const unsigned og = xb_add(&bar[XB_TOP], 1u);
            const unsigned tg = og / nx;
            if (og + 1u == (tg + 1u) * nx) xb_add(&bar[XB_TOPGEN], 1u);
            else XB_SPIN(xb_ld(&bar[XB_TOPGEN]) == tg, bar);
            __builtin_amdgcn_fence(__ATOMIC_ACQUIRE, "agent");
            xb_add(&bar[XB_XGEN(b.x)], 1u);
            asm volatile("s_waitcnt vmcnt(0)" ::: "memory");
        } else {
            XB_SPIN(xb_ld(&bar[XB_XGEN(b.x)]) == gen, bar);
            __builtin_amdgcn_fence(__ATOMIC_ACQUIRE, "agent");
            asm volatile("s_waitcnt vmcnt(0)" ::: "memory");
        }
    }
    __syncthreads();
}
struct Frame {
    LAS unsigned char* lds;
    volatile LAS unsigned* MISC;
    gu32* ctl;
    int tid, lane, wave;
    int vcu, G;
    const float* in[19];
    float* X;
    bf16 *W1T, *WDT, *WINT, *WOUTT, *POOLWT, *SGUWB;
    bf16 *XB, *HID, *PRJ, *MIX; float* PART;
};
__device__ __forceinline__ float wave_sum(float v) {
#pragma unroll
    for (int o = 1; o < 64; o <<= 1) v += __shfl_xor(v, o);
    return v;
}
__device__ __forceinline__ unsigned cvtpk(float lo, float hi) { return pg8::cvt_pk_bf16(lo, hi); }
__device__ __forceinline__ float bflo(unsigned w) { return __builtin_bit_cast(float, w << 16); }
__device__ __forceinline__ float bfhi(unsigned w) { return __builtin_bit_cast(float, w & 0xffff0000u); }
__device__ __forceinline__ float gelu_tanh(float x) {
    const float y = 0.7978845608028654f * (x + 0.044715f * x * x * x);
    const float e = __builtin_amdgcn_exp2f(-2.8853900817779268f * y);
    return x * __builtin_amdgcn_rcpf(1.0f + e);
}

constexpr int I_GU = (D / 64) * (FF / 64), I_DN = (FF / 64) * (D / 64), I_IN = (D / 64) * (PROJ / 64), I_OUT = (D / 64) * (D / 64);
constexpr int PER_LAYER = 6 * I_GU + I_IN + I_OUT;
static_assert(I_GU == I_DN, "item counts");
__device__ __forceinline__ void tr_decode(Frame& F, int l, int it, const float*& W, const float*& gk, bf16*& Bt, int& N, int& K, int& k0, int& n0, int& nrow0) {
    int r = it;
    const int ffn = (r >= 3 * I_GU + I_IN + I_OUT) ? 1 : 0;
    if (ffn) r -= 3 * I_GU + I_IN + I_OUT;
    const float* const gate = (ffn ? F.in[15] : F.in[2]) + (size_t)l * D * FF; const float* const up = (ffn ? F.in[16] : F.in[3]) + (size_t)l * D * FF; const float* const down = (ffn ? F.in[17] : F.in[4]) + (size_t)l * FF * D;
    const float* const g1 = (ffn ? F.in[14] : F.in[1]) + (size_t)l * D;
    if (r < 3 * I_GU) {
        if (r < 2 * I_GU) { const int isup = r >= I_GU; if (isup) r -= I_GU; const int kb = r / (FF / 64), nb = r % (FF / 64);
            W = isup ? up : gate; gk = g1; Bt = F.W1T + (size_t)(l * 2 + ffn) * (2 * FF) * D; N = FF; K = D; k0 = kb * 64; n0 = nb * 64; nrow0 = ((nb * 64) >> 7) * 256 + ((nb * 64) & 127) + (isup ? 128 : 0); }
        else { r -= 2 * I_GU; const int kb = r / (D / 64), nb = r % (D / 64);
            W = down; gk = nullptr; Bt = F.WDT + (size_t)(l * 2 + ffn) * D * FF; N = D; K = FF; k0 = kb * 64; n0 = nb * 64; nrow0 = nb * 64; }
    } else { r -= 3 * I_GU;
        if (r < I_IN) { const int kb = r / (PROJ / 64), nb = r % (PROJ / 64);
            W = F.in[6] + (size_t)l * D * PROJ; gk = F.in[5] + (size_t)l * D; Bt = F.WINT + (size_t)l * PROJ * D; N = PROJ; K = D; k0 = kb * 64; n0 = nb * 64;
            { const int jg = n0 - C_GC, jx = n0 - C_XC;
                nrow0 = (n0 < C_GC || n0 >= C_U) ? n0 : (n0 < C_XC) ? C_GC + (jg >> 7) * 256 + (jg & 127) : C_GC + (jx >> 7) * 256 + 128 + (jx & 127); } }
        else { r -= I_IN; const int kb = r / (D / 64), nb = r % (D / 64);
            W = F.in[13] + (size_t)l * D * D; gk = nullptr; Bt = F.WOUTT + (size_t)l * D * D; N = D; K = D; k0 = kb * 64; n0 = nb * 64; nrow0 = nb * 64; }
    }
}
#define TR_LOAD(v, W, N, k0, n0) do { _Pragma("unroll") for (int i = 0; i < 16; ++i) v[i] = __builtin_nontemporal_load((const GAS f32x4*)((W) + (size_t)((k0) + 4 * i + kq) * (N) + (n0) + 4 * nq)); } while (0)
#define TR_EMIT(v, gk, Bt, K, k0, nrow0) do { float sc[16];                      \
        if (gk) { _Pragma("unroll") for (int i = 0; i < 16; ++i) sc[i] = (gk)[(k0) + 4 * i + kq]; } else { _Pragma("unroll") for (int i = 0; i < 16; ++i) sc[i] = 1.0f; } \
        _Pragma("unroll") for (int i = 0; i < 16; ++i) { const int kk = 4 * i + kq; const float s = sc[i]; \
            T[(4 * nq + 0) * 65 + kk] = v[i][0] * s; T[(4 * nq + 1) * 65 + kk] = v[i][1] * s; T[(4 * nq + 2) * 65 + kk] = v[i][2] * s; T[(4 * nq + 3) * 65 + kk] = v[i][3] * s; } \
        LDS_WAIT(); asm volatile("" ::: "memory"); \
        _Pragma("unroll") for (int j = 0; j < 8; ++j) { const int n = (lane >> 3) + 8 * j; const LAS float* p = T + n * 65 + 8 * c; \
            v4u o; o.x = cvtpk(p[0], p[1]); o.y = cvtpk(p[2], p[3]); o.z = cvtpk(p[4], p[5]); o.w = cvtpk(p[6], p[7]); \
            __builtin_nontemporal_store(o, (GAS v4u*)((Bt) + (size_t)((nrow0) + n) * (K) + (k0) + 8 * c)); } \
        LDS_WAIT(); asm volatile("" ::: "memory"); } while (0)
__device__ __forceinline__ void convert_items(Frame& F, int l, int it0, int it1, int wrank, int nw) {
    LAS float* T = (LAS float*)(F.lds + F.wave * 16640);
    int it = it0 + wrank; if (it >= it1) return;
    const int lane = F.lane, kq = lane >> 4, nq = lane & 15, c = lane & 7;
    f32x4 va[16], vb[16];
    const float *Wa, *ga, *Wb, *gb; bf16 *Ba, *Bb; int Na, Ka, k0a, n0a, nra, Nb, Kb, k0b, n0b, nrb;
    tr_decode(F, l, it, Wa, ga, Ba, Na, Ka, k0a, n0a, nra); TR_LOAD(va, Wa, Na, k0a, n0a);
    bool hb = it + nw < it1;
    if (hb) { tr_decode(F, l, it + nw, Wb, gb, Bb, Nb, Kb, k0b, n0b, nrb); TR_LOAD(vb, Wb, Nb, k0b, n0b); }
    for (;;) {
        TR_EMIT(va, ga, Ba, Ka, k0a, nra);
        if (!hb) break;
        it += 2 * nw; const bool ha = it < it1;
        if (ha) { tr_decode(F, l, it, Wa, ga, Ba, Na, Ka, k0a, n0a, nra); TR_LOAD(va, Wa, Na, k0a, n0a); }
        TR_EMIT(vb, gb, Bb, Kb, k0b, nrb);
        if (!ha) break;
        hb = it + nw < it1;
        if (hb) { tr_decode(F, l, it + nw, Wb, gb, Bb, Nb, Kb, k0b, n0b, nrb); TR_LOAD(vb, Wb, Nb, k0b, n0b); }
    }
}
#undef TR_LOAD
#undef TR_EMIT
constexpr int IT_GU = 2 * I_GU, IT_A_END = 3 * I_GU + I_IN;
__device__ __forceinline__ void p0_prologue(Frame& F) {
    const int gw = F.vcu * NWAVES + F.wave, NGW = F.G * NWAVES;
    if (MK_TAILFILL && F.G == 256) convert_items(F, 0, 0, IT_GU, gw, NGW);
    else for (int l = 0; l < DEPTH; ++l) convert_items(F, l, 0, PER_LAYER, gw, NGW);
    const int gt = F.vcu * (NWAVES * 64) + F.tid, NGT = F.G * NWAVES * 64;
    for (int i = gt; i < DEPTH * 4 * 256 * 32; i += NGT) { const int c8 = i & 31, d = (i >> 5) & 255, lg = i >> 13;
        const float* src = F.in[7] + ((size_t)lg * 256 + 8 * c8) * 256 + d; const float sc = F.in[8][(size_t)lg * 256 + d];
        v4u o; o.x = cvtpk(src[0 * 256] * sc, src[1 * 256] * sc); o.y = cvtpk(src[2 * 256] * sc, src[3 * 256] * sc); o.z = cvtpk(src[4 * 256] * sc, src[5 * 256] * sc); o.w = cvtpk(src[6 * 256] * sc, src[7 * 256] * sc);
        *(GAS v4u*)(F.POOLWT + ((size_t)lg * 256 + d) * 256 + 8 * c8) = o; }
    for (int i = gt; i < DEPTH * 12 * 128 * 16; i += NGT) { const int s8 = i & 15, t = (i >> 4) & 127; const float* src = F.in[11] + (size_t)i * 8; float w[8];
#pragma unroll
        for (int j = 0; j < 8; ++j) w[j] = (8 * s8 + j <= t) ? src[j] : 0.f;
        v4u o; o.x = cvtpk(w[0], w[1]); o.y = cvtpk(w[2], w[3]); o.z = cvtpk(w[4], w[5]); o.w = cvtpk(w[6], w[7]);
        *(GAS v4u*)(F.SGUWB + (size_t)i * 8) = o; }
    for (int m = gw; m < M; m += NGW) { const GAS f32x4* xr = (const GAS f32x4*)(F.in[0] + (size_t)m * D) + F.lane; float ss = 0.f;
        GAS unsigned long long* o8 = (GAS unsigned long long*)(F.XB + (size_t)m * D) + F.lane;
#pragma unroll
        for (int j = 0; j < 16; ++j) { const f32x4 v = xr[64 * j]; ss += (v.x * v.x + v.y * v.y) + (v.z * v.z + v.w * v.w);
            o8[64 * j] = (unsigned long long)cvtpk(v.x, v.y) | ((unsigned long long)cvtpk(v.z, v.w) << 32); }
        ss = wave_sum(ss);
        if (F.lane < 16) F.PART[(size_t)m * 16 + F.lane] = (F.lane == 0) ? ss : 0.f; }
}

template <int W> __device__ __forceinline__ void pool_window(Frame& F, const bf16* prj, int R0, int g, LAS unsigned char* PA) {
    const int c8 = F.tid & 31, seg = F.tid >> 5, t0 = seg * 8;
    const int tl0 = (R0 & (SEQ - 1)) + t0;
    const bf16* src = prj + (size_t)(R0 + t0) * PRJ_LD + P_A + g * 256 + c8 * 8;
    v4u rows[8 + W - 1];
#pragma unroll
    for (int i = 0; i < 8 + W - 1; ++i) { const int dt = i - (W - 1); rows[i] = (tl0 + dt >= 0) ? *(const GAS v4u*)(src + (ptrdiff_t)dt * PRJ_LD) : (v4u){0u, 0u, 0u, 0u}; }
    float S[8];
#pragma unroll
    for (int j = 0; j < 8; ++j) S[j] = 0.f;
#pragma unroll
    for (int i = 0; i < W - 1; ++i) { const v4u r = rows[i]; S[0] += bflo(r.x); S[1] += bfhi(r.x); S[2] += bflo(r.y); S[3] += bfhi(r.y); S[4] += bflo(r.z); S[5] += bfhi(r.z); S[6] += bflo(r.w); S[7] += bfhi(r.w); }
#pragma unroll
    for (int t = 0; t < 8; ++t) { const v4u r = rows[t + W - 1];
        const float a[8] = {bflo(r.x), bfhi(r.x), bflo(r.y), bfhi(r.y), bflo(r.z), bfhi(r.z), bflo(r.w), bfhi(r.w)};
#pragma unroll
        for (int j = 0; j < 8; ++j) S[j] += a[j];
        const int cnt = (tl0 + t + 1 < W) ? (tl0 + t + 1) : W; const float ic = 1.0f / (float)cnt;
        v4u o; o.x = cvtpk(S[0] * ic - a[0], S[1] * ic - a[1]); o.y = cvtpk(S[2] * ic - a[2], S[3] * ic - a[3]); o.z = cvtpk(S[4] * ic - a[4], S[5] * ic - a[5]); o.w = cvtpk(S[6] * ic - a[6], S[7] * ic - a[7]);
        *(LAS v4u*)(PA + (t0 + t) * 528 + c8 * 16) = o;
        const v4u q = rows[t];
        S[0] -= bflo(q.x); S[1] -= bfhi(q.x); S[2] -= bflo(q.y); S[3] -= bfhi(q.y); S[4] -= bflo(q.z); S[5] -= bfhi(q.z); S[6] -= bflo(q.w); S[7] -= bfhi(q.w); }
}
__device__ __forceinline__ void pool_unit(Frame& F, int l, int ck, int g) {
    LAS unsigned char* PA = F.lds;
    LAS unsigned char* WH = F.lds + 67584;
    const int R0 = ck * 128;
    const bf16* Wt = F.POOLWT + (size_t)(l * 4 + g) * 256 * 256;
    const int wrow = F.tid >> 5, wch = F.tid & 31;
    v4u w0[8], w1[8];
#pragma unroll
    for (int j = 0; j < 8; ++j) w0[j] = *(const GAS v4u*)(Wt + (size_t)(wrow + 16 * j) * 256 + wch * 8);
    if (g == 0) pool_window<2>(F, F.PRJ, R0, g, PA); else if (g == 1) pool_window<4>(F, F.PRJ, R0, g, PA); else if (g == 2) pool_window<8>(F, F.PRJ, R0, g, PA); else pool_window<16>(F, F.PRJ, R0, g, PA);
#pragma unroll
    for (int j = 0; j < 8; ++j) *(LAS v4u*)(WH + (wrow + 16 * j) * 528 + wch * 16) = w0[j];
#pragma unroll
    for (int j = 0; j < 8; ++j) w1[j] = *(const GAS v4u*)(Wt + (size_t)(128 + wrow + 16 * j) * 256 + wch * 8);
    __syncthreads();
    const int fr = F.lane & 15, fq = F.lane >> 4, w = F.wave;
    bf16x8 af[8];
#pragma unroll
    for (int kk = 0; kk < 8; ++kk) af[kk] = *(const LAS bf16x8*)(PA + (16 * w + fr) * 528 + kk * 64 + fq * 16);
    bf16* orow = F.MIX + (size_t)(R0 + 16 * w + fr) * D + O_YA + g * 256 + 4 * fq;
#pragma unroll
    for (int half = 0; half < 2; ++half) {
#pragma unroll 2
        for (int n = 0; n < 8; ++n) { f32x4 acc = {0.f, 0.f, 0.f, 0.f}; const LAS unsigned char* wp = WH + (16 * n + fr) * 528 + fq * 16;
#pragma unroll
            for (int kk = 0; kk < 8; ++kk) { const bf16x8 bfrag = *(const LAS bf16x8*)(wp + kk * 64); acc = __builtin_amdgcn_mfma_f32_16x16x32_bf16(bfrag, af[kk], acc, 0, 0, 0); }
            *(GAS unsigned long long*)(orow + 128 * half + 16 * n) = (unsigned long long)cvtpk(acc[0], acc[1]) | ((unsigned long long)cvtpk(acc[2], acc[3]) << 32); }
        __syncthreads();
        if (half == 0) {
#pragma unroll
            for (int j = 0; j < 8; ++j) *(LAS v4u*)(WH + (wrow + 16 * j) * 528 + wch * 16) = w1[j];
            __syncthreads(); }
    }
}
__device__ __forceinline__ void sgu_unit(Frame& F, int l, int ck, int h) {
    LAS unsigned char* VT = F.lds + 69632;
    const int R0 = ck * 128;
    const int fr = F.lane & 15, fq = F.lane >> 4, w = F.wave, t = 16 * w + fr;
    const int s = F.tid >> 2, q = F.tid & 3;
    const bf16* src = F.PRJ + (size_t)(R0 + s) * PRJ_LD + P_V + h * 128 + q * 32;
    v4u vr[4];
#pragma unroll
    for (int i = 0; i < 4; ++i) vr[i] = *(const GAS v4u*)(src + 8 * i);
    const bf16* ws = F.SGUWB + ((size_t)(l * 12 + h) * 128 + t) * 128 + fq * 8;
    bf16x8 af[4];
#pragma unroll
    for (int kk = 0; kk < 4; ++kk) af[kk] = *(const GAS bf16x8*)(ws + kk * 32);
    const bf16* up = F.PRJ + (size_t)(R0 + t) * PRJ_LD + P_U + h * 128 + 4 * fq;
    unsigned long long uu[8];
#pragma unroll
    for (int n = 0; n < 8; ++n) uu[n] = *(const GAS unsigned long long*)(up + 16 * n);
    const float bias = F.in[12][(size_t)(l * 12 + h) * 128 + t];
    { float x[32];
#pragma unroll
        for (int i = 0; i < 4; ++i) { const v4u r = vr[i];
            x[8 * i + 0] = gelu_tanh(bflo(r.x)); x[8 * i + 1] = gelu_tanh(bfhi(r.x)); x[8 * i + 2] = gelu_tanh(bflo(r.y)); x[8 * i + 3] = gelu_tanh(bfhi(r.y));
            x[8 * i + 4] = gelu_tanh(bflo(r.z)); x[8 * i + 5] = gelu_tanh(bfhi(r.z)); x[8 * i + 6] = gelu_tanh(bflo(r.w)); x[8 * i + 7] = gelu_tanh(bfhi(r.w)); }
        float sm = 0.f;
#pragma unroll
        for (int i = 0; i < 32; ++i) sm += x[i];
        sm += __shfl_xor(sm, 1); sm += __shfl_xor(sm, 2);
        const float mu = sm * (1.0f / 128.0f); float sq = 0.f;
#pragma unroll
        for (int i = 0; i < 32; ++i) { x[i] -= mu; sq += x[i] * x[i]; }
        sq += __shfl_xor(sq, 1); sq += __shfl_xor(sq, 2);
        const float rstd = __builtin_amdgcn_rsqf(sq * (1.0f / 128.0f) + LN_EPS);
        const float* lg = F.in[10] + (size_t)l * SGU_W + h * 128 + q * 32;
#pragma unroll
        for (int i = 0; i < 32; ++i) { const float y = x[i] * rstd * lg[i]; *(LAS unsigned short*)(VT + (q * 32 + i) * 272 + s * 2) = (unsigned short)(cvtpk(y, y) & 0xffffu); }
    }
    __syncthreads();
    f32x4 acc[8];
#pragma unroll
    for (int n = 0; n < 8; ++n) acc[n] = (f32x4){0.f, 0.f, 0.f, 0.f};
    const int nk = (16 * w + 15) / 32 + 1;
#pragma unroll
    for (int kk = 0; kk < 4; ++kk) if (kk < nk) {
#pragma unroll
        for (int n = 0; n < 8; ++n) { const bf16x8 bfrag = *(const LAS bf16x8*)(VT + (16 * n + fr) * 272 + kk * 64 + fq * 16); acc[n] = __builtin_amdgcn_mfma_f32_16x16x32_bf16(bfrag, af[kk], acc[n], 0, 0, 0); } }
    bf16* op = F.MIX + (size_t)(R0 + t) * D + O_YC + h * 128 + 4 * fq;
#pragma unroll
    for (int n = 0; n < 8; ++n) { const unsigned u0 = (unsigned)uu[n], u1 = (unsigned)(uu[n] >> 32);
        const float y0 = gelu_tanh(bflo(u0)) * (acc[n][0] + bias), y1 = gelu_tanh(bfhi(u0)) * (acc[n][1] + bias), y2 = gelu_tanh(bflo(u1)) * (acc[n][2] + bias), y3 = gelu_tanh(bfhi(u1)) * (acc[n][3] + bias);
        *(GAS unsigned long long*)(op + 16 * n) = (unsigned long long)cvtpk(y0, y1) | ((unsigned long long)cvtpk(y2, y3) << 32); }
    __syncthreads();
}
__device__ __forceinline__ void mixer_phase(Frame& F, int l) {
    const int b = F.vcu;
    for (int u = b; u < (M / 128) * 4; u += F.G) pool_unit(F, l, u >> 2, u & 3);
    for (int u = b; u < (M / 128) * 12; u += F.G) sgu_unit(F, l, u / 12, u % 12);
    const float* cw = F.in[9] + (size_t)l * 3 * CONV_W;
    const int gt = b * (NWAVES * 64) + F.tid, NGT = F.G * NWAVES * 64;
    for (int item = gt; item < (M / 16) * (CONV_W / 8); item += NGT) { const int seg = item / (CONV_W / 8), c = (item - seg * (CONV_W / 8)) * 8, row0 = seg * 16, tl0 = row0 & (SEQ - 1);
        const bf16* p = F.PRJ + (size_t)row0 * PRJ_LD + c; bf16* o = F.MIX + (size_t)row0 * D + O_YB + c;
        float w0[8], w1[8], w2[8], z1[8], z2[8];
#pragma unroll
        for (int j = 0; j < 8; ++j) { w0[j] = cw[c + j]; w1[j] = cw[CONV_W + c + j]; w2[j] = cw[2 * CONV_W + c + j]; z1[j] = 0.f; z2[j] = 0.f; }
        if (tl0 >= 2) {
            const v4u q1 = *(const GAS v4u*)(p - PRJ_LD + P_Z), q2 = *(const GAS v4u*)(p - 2 * PRJ_LD + P_Z);
            z1[0] = bflo(q1.x); z1[1] = bfhi(q1.x); z1[2] = bflo(q1.y); z1[3] = bfhi(q1.y); z1[4] = bflo(q1.z); z1[5] = bfhi(q1.z); z1[6] = bflo(q1.w); z1[7] = bfhi(q1.w);
            z2[0] = bflo(q2.x); z2[1] = bfhi(q2.x); z2[2] = bflo(q2.y); z2[3] = bfhi(q2.y); z2[4] = bflo(q2.z); z2[5] = bfhi(q2.z); z2[6] = bflo(q2.w); z2[7] = bfhi(q2.w); }
#pragma unroll
        for (int rb = 0; rb < 16; rb += 8) { v4u gb[8], zz[8];
#pragma unroll
            for (int r = 0; r < 8; ++r) { const bf16* pr = p + (size_t)(rb + r) * PRJ_LD; gb[r] = *(const GAS v4u*)(pr + P_GB); zz[r] = *(const GAS v4u*)(pr + P_Z); }
#pragma unroll
            for (int r = 0; r < 8; ++r) {
                const float gbf[8] = {bflo(gb[r].x), bfhi(gb[r].x), bflo(gb[r].y), bfhi(gb[r].y), bflo(gb[r].z), bfhi(gb[r].z), bflo(gb[r].w), bfhi(gb[r].w)};
                const float z0[8] = {bflo(zz[r].x), bfhi(zz[r].x), bflo(zz[r].y), bfhi(zz[r].y), bflo(zz[r].z), bfhi(zz[r].z), bflo(zz[r].w), bfhi(zz[r].w)};
                float y[8];
#pragma unroll
                for (int j = 0; j < 8; ++j) { y[j] = gbf[j] * (w0[j] * z2[j] + w1[j] * z1[j] + w2[j] * z0[j]); z2[j] = z1[j]; z1[j] = z0[j]; }
                *(GAS v4u*)(o + (size_t)(rb + r) * D) = (v4u){cvtpk(y[0], y[1]), cvtpk(y[2], y[3]), cvtpk(y[4], y[5]), cvtpk(y[6], y[7])}; } }
    }
}
__device__ __forceinline__ void final_norm(Frame& F) {
    const int gw = F.vcu * NWAVES + F.wave, NGW = F.G * NWAVES;
    for (int m = gw; m < M; m += NGW) { const GAS v4u* xr = (const GAS v4u*)(F.XB + (size_t)m * D) + F.lane; v4u v[8]; float ss = 0.f;
#pragma unroll
        for (int j = 0; j < 8; ++j) { v[j] = xr[64 * j]; const float a0 = bflo(v[j].x), a1 = bfhi(v[j].x), a2 = bflo(v[j].y), a3 = bfhi(v[j].y), a4 = bflo(v[j].z), a5 = bfhi(v[j].z), a6 = bflo(v[j].w), a7 = bfhi(v[j].w);
            ss += ((a0 * a0 + a1 * a1) + (a2 * a2 + a3 * a3)) + ((a4 * a4 + a5 * a5) + (a6 * a6 + a7 * a7)); }
        const float rs = 1.0f / sqrtf(wave_sum(ss) * (1.0f / D) + NORM_EPS);
        GAS f32x4* o = (GAS f32x4*)(F.X + (size_t)m * D); const GAS f32x4* gn = (const GAS f32x4*)F.in[18];
#pragma unroll
        for (int j = 0; j < 8; ++j) { const int q = 2 * (F.lane + 64 * j); const f32x4 g0 = gn[q], g1 = gn[q + 1];
            o[q] = (f32x4){bflo(v[j].x) * rs * g0[0], bfhi(v[j].x) * rs * g0[1], bflo(v[j].y) * rs * g0[2], bfhi(v[j].y) * rs * g0[3]};
            o[q + 1] = (f32x4){bflo(v[j].z) * rs * g1[0], bfhi(v[j].z) * rs * g1[1], bflo(v[j].w) * rs * g1[2], bfhi(v[j].w) * rs * g1[3]}; } }
}
__device__ __forceinline__ void fill_rstd(Frame& F, LAS float* rtab, int pm) {
    if (F.tid < 256) rtab[F.tid] = pg8::row_rstd(F.PART, pm * 256 + F.tid, 1.0f / D, NORM_EPS);
    __syncthreads();
}

struct Args { const float* in[19]; float* out; unsigned char* ws; int ph_lo, ph_hi; };
static_assert(sizeof(Args) == 21 * 8 + 8, "Args has no holes");
__global__ void __launch_bounds__(NWAVES * 64, 2) mk_fwd(Args args) {
    extern __shared__ __attribute__((aligned(16))) unsigned char lds[];
    Frame F;
    F.lds = (LAS unsigned char*)lds;
    F.MISC = (volatile LAS unsigned*)(F.lds + MISC_OFF);
    F.tid = threadIdx.x; F.lane = F.tid & 63; F.wave = __builtin_amdgcn_readfirstlane(F.tid >> 6);
    F.G = gridDim.x; { const int bx = blockIdx.x; F.vcu = (F.G % 8 == 0) ? (bx % 8) * (F.G / 8) + bx / 8 : bx; }
    unsigned char* ws = args.ws;
    F.ctl = (gu32*)(ws + WS_CTL);
#pragma unroll
    for (int i = 0; i < 19; ++i) F.in[i] = args.in[i];
    F.X = args.out;
    F.W1T = (bf16*)(ws + WS_W1); F.WDT = (bf16*)(ws + WS_WD); F.WINT = (bf16*)(ws + WS_WIN); F.WOUTT = (bf16*)(ws + WS_WOUT); F.POOLWT = (bf16*)(ws + WS_POOLW); F.SGUWB = (bf16*)(ws + WS_SGUW);
    F.XB = (bf16*)(ws + WS_XB); F.HID = (bf16*)(ws + WS_HID); F.PRJ = (bf16*)(ws + WS_PROJ); F.MIX = (bf16*)(ws + WS_MIX); F.PART = (float*)(ws + WS_PART);
    if (F.tid < 64) ((LAS unsigned*)(F.lds + MISC_OFF))[F.tid] = 0u;
    __syncthreads();
    XcdBarrier bar = xcd_barrier_post((unsigned*)(F.ctl + CW_BAR), F.MISC + 8);
    const int lo = args.ph_lo, hi = args.ph_hi;
#define IN(k) (lo <= (k) && (k) < hi)
#define SEAM(k) do { if (IN(k) && IN((k) + 1)) xcd_barrier(bar); } while (0)
    LAS float* scr = (LAS float*)(F.lds + SCR_OFF);

    if (IN(0)) p0_prologue(F);
    SEAM(0);
    int ph = 1;
    for (int s = 0; s < 2 * DEPTH; ++s) {
        const int l = s >> 1, second = s & 1;
        const bf16* xb = F.XB; const bf16* hid = F.HID; const bf16* mix = F.MIX; int cblk = (int)blockIdx.x;
        asm volatile("" : "+s"(xb), "+s"(hid), "+s"(mix), "+s"(cblk));
        F.tid = threadIdx.x; asm volatile("" : "+v"(F.tid)); F.lane = F.tid & 63; F.wave = __builtin_amdgcn_readfirstlane(F.tid >> 6);
        asm volatile("" : "+s"(F.vcu));
        if (IN(ph)) { pg8::Gemm g{xb, F.W1T + (size_t)s * (2 * FF) * D, M, 2 * FF, D}; pg8::StaticOrder S; S.init(M, 2 * FF, F.G, cblk);
            pg8::Unit u0; u0.pm = 0; u0.pn = 0; (void)S.next(0, u0); fill_rstd(F, scr, u0.pm);
            pg8::EpiSwiglu E{F.HID, FF, F.PART, 1.0f / D, NORM_EPS, scr, u0.pm};
            pg8::gemm_phase<pg8::EpiSwiglu, pg8::StaticOrder, PG8_ALIGN, PG8_SP2>(F.lds + RING_OFF, g, S, E);
#if MK_TAILFILL
            { constexpr int REM = ((M / 256) * (2 * FF / 256)) % 256;
                if (REM > 0 && F.G == 256 && cblk >= REM) { const int wr_ = (cblk - REM) * NWAVES + F.wave, nw_ = (256 - REM) * NWAVES;
                    if (!second) convert_items(F, l, IT_GU, IT_A_END, wr_, nw_); else if (l + 1 < DEPTH) convert_items(F, l + 1, 0, IT_GU, wr_, nw_); } }
#endif
        }
        SEAM(ph); ++ph;
        if (IN(ph)) { pg8::Gemm g{hid, F.WDT + (size_t)s * D * FF, M, D, FF}; pg8::StaticOrder S; S.init(M, D, F.G, cblk);
            pg8::EpiResid E{F.XB, F.PART, D, 0.5f, scr};
            pg8::gemm_phase<pg8::EpiResid, pg8::StaticOrder, PG8_ALIGN, PG8_SP2>(F.lds + RING_OFF, g, S, E); }
        SEAM(ph); ++ph;
        if (!second) {
            if (IN(ph)) { pg8::Gemm g{xb, F.WINT + (size_t)l * PROJ * D, M, PROJ, D}; pg8::StaticOrder S; S.init(M, PROJ, F.G, cblk);
                pg8::Unit u0; u0.pm = 0; u0.pn = 0; (void)S.next(0, u0); fill_rstd(F, scr, u0.pm);
                pg8::EpiScaleBf16 E{F.PRJ, PRJ_LD, F.PART, 1.0f / D, NORM_EPS, scr, u0.pm, Z_LO, Z_HI};
                pg8::gemm_phase<pg8::EpiScaleBf16, pg8::StaticOrder, PG8_ALIGN, PG8_SP2>(F.lds + RING_OFF, g, S, E);
#if MK_TAILFILL
                { constexpr int REM = ((M / 256) * (PROJ / 256)) % 256;
                    if (REM > 0 && F.G == 256 && cblk >= REM) convert_items(F, l, IT_A_END, PER_LAYER, (cblk - REM) * NWAVES + F.wave, (256 - REM) * NWAVES); }
#endif
            }
            SEAM(ph); ++ph;
            if (IN(ph)) mixer_phase(F, l);
            SEAM(ph); ++ph;
            if (IN(ph)) { pg8::Gemm g{mix, F.WOUTT + (size_t)l * D * D, M, D, D}; pg8::StaticOrder S; S.init(M, D, F.G, cblk);
                pg8::EpiResid E{F.XB, F.PART, D, 1.0f, scr};
                pg8::gemm_phase<pg8::EpiResid, pg8::StaticOrder, PG8_ALIGN, PG8_SP2>(F.lds + RING_OFF, g, S, E); }
            SEAM(ph); ++ph;
        }
    }
    F.tid = threadIdx.x; asm volatile("" : "+v"(F.tid)); F.lane = F.tid & 63; F.wave = __builtin_amdgcn_readfirstlane(F.tid >> 6);
    if (IN(ph)) final_norm(F);
#undef IN
#undef SEAM
}

extern "C" void kernel_launch(void* const* d_in, const int* in_sizes, int n_in, void* d_out, int out_size, void* d_ws, size_t ws_size, hipStream_t stream) {
    static int grid = 0;
    if (grid == 0) {
        if (n_in != 19 || in_sizes[0] != M * D || out_size != M * D || ws_size < WS_END) { fprintf(stderr, "kernel_launch: built for 19 inputs, x and out of %d floats, >= %zu bytes of workspace; got n_in %d, in0 %d, out %d, ws %zu; nothing launched\n", M * D, (size_t)WS_END, n_in, n_in > 0 ? in_sizes[0] : -1, out_size, ws_size); grid = -1; return; }
        int dev = 0, cus = 0, per_cu = 0;
        if (hipGetDevice(&dev) != hipSuccess || hipDeviceGetAttribute(&cus, hipDeviceAttributeMultiprocessorCount, dev) != hipSuccess) { fprintf(stderr, "kernel_launch: hipGetDevice / hipDeviceGetAttribute failed; nothing launched\n"); grid = -1; return; }
        if (hipFuncSetAttribute((const void*)mk_fwd, hipFuncAttributeMaxDynamicSharedMemorySize, LDS_BYTES) != hipSuccess) { fprintf(stderr, "kernel_launch: hipFuncSetAttribute failed\n"); grid = -1; return; }
        if (hipOccupancyMaxActiveBlocksPerMultiprocessor(&per_cu, (const void*)mk_fwd, NWAVES * 64, LDS_BYTES) != hipSuccess || per_cu < 1) fprintf(stderr, "kernel_launch: note: occupancy query reports %d workgroups per CU; launching one per CU anyway\n", per_cu);
        (void)hipGetLastError();
        grid = cus;
    }
    if (grid < 0) return;
    if (hipMemsetAsync((char*)d_ws + WS_CTL, 0, CTL_ZERO_BYTES, stream) != hipSuccess) { fprintf(stderr, "kernel_launch: hipMemsetAsync of the control words failed; nothing launched\n"); return; }
    Args a{};
    for (int i = 0; i < 19; ++i) a.in[i] = (const float*)d_in[i];
    a.out = (float*)d_out; a.ws = (unsigned char*)d_ws;
#if MK_PER_PHASE
    for (int p = 0; p < NPHASES; ++p) { a.ph_lo = p; a.ph_hi = p + 1; hipLaunchKernelGGL(mk_fwd, dim3(grid), dim3(NWAVES * 64), LDS_BYTES, stream, a); }
#else
    a.ph_lo = 0; a.ph_hi = NPHASES;
    hipLaunchKernelGGL(mk_fwd, dim3(grid), dim3(NWAVES * 64), LDS_BYTES, stream, a);
#endif
    const hipError_t le = hipPeekAtLastError();
    if (le != hipSuccess) fprintf(stderr, "kernel_launch: launch failed: %s (grid %d x %d threads, %d B LDS)\n", hipGetErrorName(le), grid, NWAVES * 64, LDS_BYTES);
}
```
